# Optimizing an MI355X kernel written in HIP

```python
import jax, jax.numpy as jnp
from jax import lax
import numpy as np

D_MODEL = 2048
BATCH = 4
SEQ = 2048
DEPTH = 2

GRID_W = 64
WIN_H_MAX = 8
WIN_W = 16
A_HEAD_DIM = 128
D_A = D_MODEL // 2
A_HEADS = D_A // A_HEAD_DIM
CHUNK = 128
D_B = D_MODEL // 4
B_GROUPS = 4
B_GROUP_DIM = D_B // B_GROUPS
D_C = D_MODEL // 4
CONV_W = 31
D_MIX = D_A + D_B + D_C
SPLIT_SIZES = [D_A] * 4 + [D_B] * 3 + [D_C] * 3
D_IN = sum(SPLIT_SIZES)
EPS = 1e-6

kernel_name = 'hybrid_natten_gmlp_conformer_encoder'


def rms_norm(x, g):
    xf = x.astype(jnp.float32)
    y = xf * lax.rsqrt(jnp.mean(xf * xf, axis=-1, keepdims=True) + EPS)
    return (y * g.astype(jnp.float32)).astype(x.dtype)


def layer_norm(x, g, b):
    xf = x.astype(jnp.float32)
    mu = jnp.mean(xf, axis=-1, keepdims=True)
    xc = xf - mu
    var = jnp.mean(xc * xc, axis=-1, keepdims=True)
    y = xc * lax.rsqrt(var + EPS) * g.astype(jnp.float32) + b.astype(jnp.float32)
    return y.astype(x.dtype)


def neighbourhood_attention(q, k, v, rpb):
    bsz, t, _ = q.shape
    rows = t // GRID_W
    kh = min(WIN_H_MAX, rows)

    def to_grid(z):
        return z.reshape(bsz, rows, GRID_W, A_HEADS, A_HEAD_DIM).transpose(0, 3, 1, 2, 4)

    qg = to_grid(q) * (A_HEAD_DIM ** -0.5)
    kg = to_grid(k)
    vg = to_grid(v)
    cols = np.arange(GRID_W)
    col_start = np.clip(cols - WIN_W // 2, 0, GRID_W - WIN_W)
    col_idx = col_start[:, None] + np.arange(WIN_W)[None, :]
    dc = col_idx - cols[:, None] + (WIN_W - 1)
    rpb_f = rpb.astype(jnp.float32)

    def one_row(r):
        rs = jnp.clip(r - kh // 2, 0, rows - kh)
        k_rows = lax.dynamic_slice_in_dim(kg, rs, kh, axis=2)
        v_rows = lax.dynamic_slice_in_dim(vg, rs, kh, axis=2)
        k_win = k_rows[:, :, :, col_idx, :]
        v_win = v_rows[:, :, :, col_idx, :]
        q_row = lax.dynamic_index_in_dim(qg, r, axis=2, keepdims=False)
        s = jnp.einsum('bhwd,bhiwjd->bhwij', q_row, k_win).astype(jnp.float32)
        dr = rs + jnp.arange(kh) - r + (WIN_H_MAX - 1)
        bias = rpb_f[:, dr][:, :, dc].transpose(0, 2, 1, 3)
        s = s + bias[None]
        p = jax.nn.softmax(s.reshape(bsz, A_HEADS, GRID_W, kh * WIN_W), axis=-1)
        p = p.reshape(bsz, A_HEADS, GRID_W, kh, WIN_W).astype(v.dtype)
        return jnp.einsum('bhwij,bhiwjd->bhwd', p, v_win)

    out = lax.map(one_row, jnp.arange(rows))
    return out.transpose(1, 0, 3, 2, 4).reshape(bsz, t, D_A)


def spatial_gating(u, v, ln_g, ln_b, w_s, b_s):
    bsz, t, _ = u.shape
    u = jax.nn.gelu(u, approximate=False)
    v = layer_norm(jax.nn.gelu(v, approximate=False), ln_g, ln_b)
    vc = v.reshape(bsz, t // CHUNK, CHUNK, B_GROUPS, B_GROUP_DIM)
    s = jnp.einsum('gts,bnsgc->bntgc', w_s, vc) + b_s.T[None, None, :, :, None]
    return u * s.reshape(bsz, t, D_B)


def conformer_conv(a, b, conv_w, conv_b, ln_g, ln_b, pw_w, pw_b):
    h = a * jax.nn.sigmoid(b)
    h = lax.conv_general_dilated(
        h, conv_w, window_strides=(1,), padding=[(CONV_W // 2, CONV_W // 2)],
        dimension_numbers=('NWC', 'WIO', 'NWC'), feature_group_count=D_C) + conv_b
    h = jax.nn.silu(layer_norm(h, ln_g, ln_b))
    return h @ pw_w + pw_b


def setup_inputs(seed: int = 0) -> dict:
    key = jax.random.key(seed)
    ks = jax.random.split(key, 16)
    f32 = jnp.float32
    nrm = lambda k, shape, s: jax.random.normal(k, shape, f32) * s
    return {
        'x': nrm(ks[0], (BATCH, SEQ, D_MODEL), 1.0),
        'pre_norm_g': 1.0 + nrm(ks[1], (DEPTH, D_MODEL), 0.02),
        'w_in': nrm(ks[2], (DEPTH, D_MODEL, D_IN), D_MODEL ** -0.5),
        'attn_rpb': nrm(ks[3], (DEPTH, A_HEADS, 2 * WIN_H_MAX - 1, 2 * WIN_W - 1), 0.1),
        'sgu_ln_g': 1.0 + nrm(ks[4], (DEPTH, D_B), 0.02),
        'sgu_ln_b': nrm(ks[5], (DEPTH, D_B), 0.01),
        'sgu_w': nrm(ks[6], (DEPTH, B_GROUPS, CHUNK, CHUNK), CHUNK ** -0.5),
        'sgu_b': 1.0 + nrm(ks[7], (DEPTH, B_GROUPS, CHUNK), 0.01),
        'conv_w': nrm(ks[8], (DEPTH, CONV_W, 1, D_C), CONV_W ** -0.5),
        'conv_b': nrm(ks[9], (DEPTH, D_C), 0.01),
        'conv_ln_g': 1.0 + nrm(ks[10], (DEPTH, D_C), 0.02),
        'conv_ln_b': nrm(ks[11], (DEPTH, D_C), 0.01),
        'conv_pw_w': nrm(ks[12], (DEPTH, D_C, D_C), D_C ** -0.5),
        'conv_pw_b': nrm(ks[13], (DEPTH, D_C), 0.01),
        'w_out': nrm(ks[14], (DEPTH, D_MIX, D_MODEL), D_MIX ** -0.5),
        'post_norm_g': 1.0 + nrm(ks[15], (DEPTH, D_MODEL), 0.02),
    }


def reference(x, pre_norm_g, w_in, attn_rpb, sgu_ln_g, sgu_ln_b, sgu_w, sgu_b,
              conv_w, conv_b, conv_ln_g, conv_ln_b, conv_pw_w, conv_pw_b,
              w_out, post_norm_g):
    offsets = np.cumsum(SPLIT_SIZES)[:-1].tolist()
    for l in range(DEPTH):
        h = rms_norm(x, pre_norm_g[l])
        z = h @ w_in[l]
        q, k, v, g_a, u_b, v_b, g_b, a_c, b_c, g_c = jnp.split(z, offsets, axis=-1)
        y_a = neighbourhood_attention(q, k, v, attn_rpb[l]) * jax.nn.silu(g_a)
        y_b = spatial_gating(u_b, v_b, sgu_ln_g[l], sgu_ln_b[l], sgu_w[l], sgu_b[l]) * jax.nn.silu(g_b)
        y_c = conformer_conv(a_c, b_c, conv_w[l], conv_b[l], conv_ln_g[l], conv_ln_b[l],
                             conv_pw_w[l], conv_pw_b[l]) * jax.nn.silu(g_c)
        y = jnp.concatenate([y_a, y_b, y_c], axis=-1) @ w_out[l]
        x = x + rms_norm(y, post_norm_g[l])
    return x
```

```cpp
#include <hip/hip_runtime.h>
#include <hip/hip_cooperative_groups.h>
#include <cstdio>
namespace cg = cooperative_groups;

#define LAS __attribute__((address_space(3)))
typedef unsigned short bf16_t;
typedef short bf16x8 __attribute__((ext_vector_type(8)));
typedef float f32x4 __attribute__((ext_vector_type(4)));
typedef float f32x2 __attribute__((ext_vector_type(2)));
typedef unsigned u32x4 __attribute__((ext_vector_type(4)));
typedef unsigned u32x2 __attribute__((ext_vector_type(2)));

constexpr int DM = 2048, NB = 4, SEQ = 2048, MTOK = NB * SEQ, DEPTH = 2;
constexpr int DIN = 7168, DMIX = 2048;
constexpr int OFF_Q = 0, OFF_K = 1024, OFF_V = 2048, OFF_GA = 3072, OFF_UB = 4096, OFF_VB = 4608, OFF_GB = 5120, OFF_AC = 5632, OFF_BC = 6144, OFF_GC = 6656;
constexpr float EPS = 1e-6f;

constexpr size_t MiB = 1u << 20;
constexpr size_t WS_WIN = 0;
constexpr size_t WS_WOUT = 56 * MiB;
constexpr size_t WS_PW = 72 * MiB;
constexpr size_t WS_SGW = 73 * MiB;
constexpr size_t WS_SSQ = 74 * MiB;
constexpr size_t WS_H = 76 * MiB;
constexpr size_t WS_Z = 108 * MiB;
constexpr size_t WS_VT = 220 * MiB;
constexpr size_t WS_YC = 236 * MiB;
constexpr size_t WS_Y = 268 * MiB;
constexpr size_t WS_X1 = 332 * MiB;
constexpr size_t WS_END = 396 * MiB;

constexpr int LDS_BYTES = 147456;

__device__ __forceinline__ unsigned cvt_pk_bf16(float lo, float hi) { unsigned r; asm volatile("v_cvt_pk_bf16_f32 %0, %1, %2" : "=v"(r) : "v"(lo), "v"(hi)); return r; }
__device__ __forceinline__ float bf_lo(unsigned w) { return __uint_as_float(w << 16); }
__device__ __forceinline__ float bf_hi(unsigned w) { return __uint_as_float(w & 0xffff0000u); }
__device__ __forceinline__ float wave_sum(float v) {
#pragma unroll
    for (int o = 1; o < 64; o <<= 1) v += __shfl_xor(v, o);
    return v;
}
__device__ __forceinline__ float gelu_f(float v) { return 0.5f * v * (1.0f + erff(v * 0.70710678118f)); }
__device__ __forceinline__ float sigmoid_f(float v) { return 1.0f / (1.0f + __expf(-v)); }
__device__ __forceinline__ float silu_f(float v) { return v / (1.0f + __expf(-v)); }
#define LDS_WAIT() asm volatile("s_waitcnt lgkmcnt(0)" ::: "memory")

namespace pg8 {
constexpr int BM = 256, BK = 64, HALF = 128, HTB = HALF * BK * 2, STAGE_BYTES = 8 * HTB, NXCD = 8, WGM = 8;
__device__ __forceinline__ int lds_byte(int r, int c) { const int st = (r >> 4) * 2 + (c >> 5), rr = r & 15, cc = c & 31, ob = rr * 64 + cc * 2; return st * 1024 + (ob ^ (((ob >> 9) & 1) << 5)); }
__device__ __forceinline__ void stage_rc(int b, int& R, int& C) { const int st = b / 1024, sb = b % 1024, swz = sb ^ (((sb >> 9) & 1) << 5); R = (st >> 1) * 16 + swz / 64; C = (st & 1) * 32 + (swz % 64) / 2; }
__device__ __forceinline__ int perm32(int rho) { const int n = rho >> 4, i = rho & 15; return 8 * (i >> 2) + 4 * n + (i & 3); }

struct Unit { int pm, pn; };
struct Gemm { const bf16_t* A; const bf16_t* Bt; int M, N, K; };

struct StaticOrder {
    int nM, nN, nwg, G, c, skip_from, skip;
    __device__ void init(int M, int N, int G_, int c_, int skip_from_, int skip_) { nM = M / BM; nN = N / BM; nwg = nM * nN; G = G_; c = c_; skip_from = skip_from_; skip = skip_; }
    __device__ bool next(int i, Unit& u) const {
        const long L = (long)i * G + c; if (L >= nwg) return false;
        int wgid = (int)L; { const int q = nwg / NXCD, r = nwg % NXCD, xcd = wgid % NXCD, off = wgid / NXCD; wgid = (xcd < r ? xcd * (q + 1) : r * (q + 1) + (xcd - r) * q) + off; }
        const int nig = WGM * nN, gid = wgid / nig, fm = gid * WGM, gsz = (nM - fm) < WGM ? (nM - fm) : WGM;
        u.pm = fm + ((wgid % nig) % gsz); u.pn = (wgid % nig) / gsz;
        if (u.pn >= skip_from) u.pn += skip;
        return true;
    }
    __device__ __forceinline__ void a_ready(const Unit&) const {}
    __device__ __forceinline__ void done(const Unit&) const {}
};

struct EpiBf16 {
    static constexpr bool PERM = true;
    bf16_t* O; int ldc;
    __device__ __forceinline__ void operator()(const f32x4 (&acc)[2][2][4][2], const Unit& u, int wr, int wc, int fr, int fq) const {
        const int row0 = u.pm * BM + wr * 64 + fr; const int col0 = u.pn * BM + wc * 32 + 8 * fq;
#pragma unroll
        for (int ai = 0; ai < 2; ++ai)
#pragma unroll
            for (int m = 0; m < 4; ++m) { bf16_t* rowp = O + (size_t)(row0 + ai * HALF + m * 16) * ldc + col0;
#pragma unroll
                for (int bj = 0; bj < 2; ++bj) { const f32x4 v0 = acc[ai][bj][m][0], v1 = acc[ai][bj][m][1];
                    u32x4 w; w.x = cvt_pk_bf16(v0[0], v0[1]); w.y = cvt_pk_bf16(v0[2], v0[3]); w.z = cvt_pk_bf16(v1[0], v1[1]); w.w = cvt_pk_bf16(v1[2], v1[3]);
                    *(u32x4*)(rowp + bj * HALF) = w; } }
    }
};
struct EpiF32Ssq {
    static constexpr bool PERM = false;
    float* C; int ldc; float* ssq;
    __device__ __forceinline__ void operator()(const f32x4 (&acc)[2][2][4][2], const Unit& u, int wr, int wc, int fr, int fq) const {
        const int row0 = u.pm * BM + wr * 64 + fr, col0 = u.pn * BM + wc * 32 + 4 * fq;
#pragma unroll
        for (int ai = 0; ai < 2; ++ai)
#pragma unroll
            for (int m = 0; m < 4; ++m) { const int row = row0 + ai * HALF + m * 16; float* rowp = C + (size_t)row * ldc + col0; float s = 0.f;
#pragma unroll
                for (int bj = 0; bj < 2; ++bj)
#pragma unroll
                    for (int n = 0; n < 2; ++n) { const f32x4 v = acc[ai][bj][m][n]; *(f32x4*)(rowp + bj * HALF + n * 16) = v; s += (v[0] * v[0] + v[1] * v[1]) + (v[2] * v[2] + v[3] * v[3]); }
                s += __shfl_xor(s, 16); s += __shfl_xor(s, 32);
                if (fq == 0) ssq[(size_t)row * 32 + u.pn * 4 + wc] = s; }
    }
};

template <class Epi, class Sched>
__device__ __forceinline__ void gemm_phase(LAS unsigned char* lds, const Gemm g, const Sched& S, const Epi& E) {
    int tid = threadIdx.x; asm volatile("" : "+v"(tid));
    const int wid = __builtin_amdgcn_readfirstlane(tid >> 6), lane = tid & 63, wr = wid >> 2, wc = wid & 3, fr = lane & 15, fq = lane >> 4;
    const int K = g.K, nt = K / BK;
    unsigned voffA[2], voffB[2];
#pragma unroll
    for (int i = 0; i < 2; ++i) { int R, C; stage_rc(tid * 16 + i * 8192, R, C); const int Rb = Epi::PERM ? ((R & ~31) + perm32(R & 31)) : R;
        voffA[i] = (unsigned)(R * K + C) * 2u; voffB[i] = (unsigned)(Rb * K + C) * 2u; }
    const size_t kstep = (size_t)(BK * 2);
    const size_t hstep = (size_t)HALF * K * 2;
    const size_t tstep = 2 * hstep;
    const unsigned ldsw = (unsigned)wid * 1024u;
    const int aoff = lds_byte(wr * 64 + fr, fq * 8), boff = lds_byte(wc * 32 + fr, fq * 8);
#define PG8_SA(b, h) (((b) * 2 + (h)) * HTB)
#define PG8_SB(b, h) ((4 + (b) * 2 + (h)) * HTB)
#define PG8_STAGE(bufoff, gbase, voff) do { _Pragma("unroll") for (int _i = 0; _i < 2; ++_i) \
        __builtin_amdgcn_global_load_lds((const unsigned*)((const char*)(gbase) + (voff)[_i]), (LAS unsigned*)(lds + (bufoff) + ldsw + _i * 8192), 16, 0, 0); } while (0)
#define PG8_LDA(dst, b, h) do { _Pragma("unroll") for (int m = 0; m < 4; ++m) _Pragma("unroll") for (int k = 0; k < 2; ++k) dst[m][k] = *(const LAS bf16x8*)(lds + PG8_SA(b, h) + aoff + m * 2048 + k * 1024); } while (0)
#define PG8_LDB(dst, b, h) do { _Pragma("unroll") for (int n = 0; n < 2; ++n) _Pragma("unroll") for (int k = 0; k < 2; ++k) dst[n][k] = *(const LAS bf16x8*)(lds + PG8_SB(b, h) + boff + n * 2048 + k * 1024); } while (0)
#define PG8_MMA(ai, bj, At, Bt) do { __builtin_amdgcn_s_setprio(1); _Pragma("unroll") for (int m = 0; m < 4; ++m) _Pragma("unroll") for (int n = 0; n < 2; ++n) _Pragma("unroll") for (int k = 0; k < 2; ++k) \
        acc[ai][bj][m][n] = __builtin_amdgcn_mfma_f32_16x16x32_bf16(Bt[n][k], At[m][k], acc[ai][bj][m][n], 0, 0, 0); __builtin_amdgcn_s_setprio(0); } while (0)
#define PG8_WAIT_V(n) asm volatile("s_waitcnt vmcnt(" #n ")" ::: "memory")
#define PG8_WAIT_L(n) asm volatile("s_waitcnt lgkmcnt(" #n ")" ::: "memory")
#define PG8_BAR __builtin_amdgcn_s_barrier()
#define PG8_SCHED __builtin_amdgcn_sched_barrier(0)
    Unit cur, nxt; int ui = 0;
    if (!S.next(0, cur)) return;
    f32x4 acc[2][2][4][2];
#pragma unroll
    for (int a = 0; a < 2; ++a)
#pragma unroll
        for (int b = 0; b < 2; ++b)
#pragma unroll
            for (int m = 0; m < 4; ++m)
#pragma unroll
                for (int n = 0; n < 2; ++n) acc[a][b][m][n] = (f32x4){0.f, 0.f, 0.f, 0.f};
    bf16x8 At[4][2], B0[2][2], B1[2][2];
    const char* cA = (const char*)g.A + (size_t)cur.pm * tstep; const char* cB = (const char*)g.Bt + (size_t)cur.pn * tstep;
    S.a_ready(cur);
    PG8_STAGE(PG8_SB(0, 0), cB, voffB); PG8_STAGE(PG8_SA(0, 0), cA, voffA); PG8_STAGE(PG8_SB(0, 1), cB + hstep, voffB); PG8_STAGE(PG8_SA(0, 1), cA + hstep, voffA);
    if (wr == 1) PG8_BAR;
    PG8_WAIT_V(4); PG8_BAR;
    PG8_STAGE(PG8_SB(1, 0), cB + kstep, voffB); PG8_STAGE(PG8_SA(1, 0), cA + kstep, voffA); PG8_STAGE(PG8_SB(1, 1), cB + hstep + kstep, voffB);
    PG8_WAIT_V(6); PG8_BAR;
    for (;;) {
        const bool has_next = S.next(ui + 1, nxt);
        const char* nA = has_next ? (const char*)g.A + (size_t)nxt.pm * tstep : cA; const char* nB = has_next ? (const char*)g.Bt + (size_t)nxt.pn * tstep : cB;
        for (int t = 0; t < nt; t += 2) {
            const bool last = (t == nt - 2);
            const char* a1 = cA + (size_t)(t + 1) * kstep;
            const char* a2 = last ? nA : cA + (size_t)(t + 2) * kstep; const char* b2 = last ? nB : cB + (size_t)(t + 2) * kstep;
            const char* a3 = a2 + kstep; const char* b3 = b2 + kstep;
            if (last && has_next) S.a_ready(nxt);
            PG8_LDB(B0, 0, 0); PG8_SCHED; PG8_LDA(At, 0, 0); PG8_STAGE(PG8_SA(1, 1), a1 + hstep, voffA);
            PG8_WAIT_L(8); PG8_BAR; PG8_WAIT_L(0); PG8_MMA(0, 0, At, B0); PG8_BAR; PG8_SCHED;
            PG8_LDB(B1, 0, 1); PG8_STAGE(PG8_SB(0, 0), b2, voffB);
            PG8_BAR; PG8_WAIT_L(0); PG8_MMA(0, 1, At, B1); PG8_BAR;
            PG8_LDA(At, 0, 1); PG8_STAGE(PG8_SA(0, 0), a2, voffA);
            PG8_BAR; PG8_WAIT_L(0); PG8_MMA(1, 0, At, B0); PG8_BAR; PG8_SCHED;
            PG8_STAGE(PG8_SB(0, 1), b2 + hstep, voffB);
            PG8_WAIT_V(6); PG8_BAR; PG8_MMA(1, 1, At, B1); PG8_BAR;
            PG8_LDB(B0, 1, 0); PG8_SCHED; PG8_LDA(At, 1, 0); PG8_STAGE(PG8_SA(0, 1), a2 + hstep, voffA);
            PG8_WAIT_L(8); PG8_BAR; PG8_WAIT_L(0); PG8_MMA(0, 0, At, B0); PG8_BAR; PG8_SCHED;
            PG8_LDB(B1, 1, 1); PG8_STAGE(PG8_SB(1, 0), b3, voffB);
            PG8_BAR; PG8_WAIT_L(0); PG8_MMA(0, 1, At, B1); PG8_BAR;
            PG8_LDA(At, 1, 1); PG8_STAGE(PG8_SA(1, 0), a3, voffA);
            PG8_BAR; PG8_WAIT_L(0); PG8_MMA(1, 0, At, B0); PG8_BAR; PG8_SCHED;
            PG8_STAGE(PG8_SB(1, 1), b3 + hstep, voffB);
            PG8_WAIT_V(6); PG8_BAR; PG8_MMA(1, 1, At, B1); PG8_BAR;
        }
        E(acc, cur, wr, wc, fr, fq); S.done(cur);
        if (!has_next) break;
#pragma unroll
        for (int a = 0; a < 2; ++a)
#pragma unroll
            for (int b = 0; b < 2; ++b)
#pragma unroll
                for (int m = 0; m < 4; ++m)
#pragma unroll
                    for (int n = 0; n < 2; ++n) acc[a][b][m][n] = (f32x4){0.f, 0.f, 0.f, 0.f};
        cur = nxt; cA = nA; cB = nB; ++ui;
    }
    PG8_WAIT_V(0);
    if (wr == 0) PG8_BAR;
    PG8_BAR;
#undef PG8_SA
#undef PG8_SB
#undef PG8_STAGE
#undef PG8_LDA
#undef PG8_LDB
#undef PG8_MMA
#undef PG8_WAIT_V
#undef PG8_WAIT_L
#undef PG8_BAR
#undef PG8_SCHED
}
}

__device__ __forceinline__ void p0_transpose_item(const float* W, int K, int N, bf16_t* WT, LAS float* scr, int item, int lane) {
    const int nblk = N / 32, kb = item / nblk, nb = item % nblk, k0 = 64 * kb, n0 = 32 * nb;
#pragma unroll 8
    for (int i = 0; i < 32; ++i) { const int kk = 2 * i + (lane >> 5); scr[kk * 33 + (lane & 31)] = W[(size_t)(k0 + kk) * N + n0 + (lane & 31)]; }
    LDS_WAIT(); asm volatile("" ::: "memory");
    const int c = lane & 7;
#pragma unroll
    for (int j = 0; j < 4; ++j) { const int n = (lane >> 3) + 8 * j; const LAS float* s = scr + (8 * c) * 33 + n;
        u32x4 o; o.x = cvt_pk_bf16(s[0 * 33], s[1 * 33]); o.y = cvt_pk_bf16(s[2 * 33], s[3 * 33]); o.z = cvt_pk_bf16(s[4 * 33], s[5 * 33]); o.w = cvt_pk_bf16(s[6 * 33], s[7 * 33]);
        *(u32x4*)(WT + (size_t)(n0 + n) * K + k0 + 8 * c) = o; }
    LDS_WAIT(); asm volatile("" ::: "memory");
}

template <bool HAS_Y, bool WRITE_X, bool WRITE_H>
__device__ __forceinline__ void row_update(const float* xrow, const float* yrow, const float* ssq_row, const float* gpost, const float* gpre, float* xout, bf16_t* hout, int lane) {
    f32x4 v[8];
    const f32x4* xr = (const f32x4*)xrow + lane;
#pragma unroll
    for (int j = 0; j < 8; ++j) v[j] = xr[64 * j];
    if (HAS_Y) {
        float s = ssq_row[lane & 31];
#pragma unroll
        for (int o = 1; o < 32; o <<= 1) s += __shfl_xor(s, o);
        const float rstd = 1.0f / sqrtf(s * (1.0f / DM) + EPS);
        const f32x4* yr = (const f32x4*)yrow + lane; const f32x4* gp = (const f32x4*)gpost + lane;
#pragma unroll
        for (int j = 0; j < 8; ++j) { const f32x4 y = yr[64 * j], g = gp[64 * j]; v[j] = v[j] + (y * rstd) * g; }
    }
    if (WRITE_X) { f32x4* xo = (f32x4*)xout + lane;
#pragma unroll
        for (int j = 0; j < 8; ++j) xo[64 * j] = v[j]; }
    if (WRITE_H) {
        float s2 = 0.f;
#pragma unroll
        for (int j = 0; j < 8; ++j) s2 += (v[j][0] * v[j][0] + v[j][1] * v[j][1]) + (v[j][2] * v[j][2] + v[j][3] * v[j][3]);
        const float rstd2 = 1.0f / sqrtf(wave_sum(s2) * (1.0f / DM) + EPS);
        const f32x4* gq = (const f32x4*)gpre + lane; u32x2* ho = (u32x2*)hout + lane;
#pragma unroll
        for (int j = 0; j < 8; ++j) { const f32x4 g = gq[64 * j]; u32x2 w; w.x = cvt_pk_bf16(v[j][0] * rstd2 * g[0], v[j][1] * rstd2 * g[1]); w.y = cvt_pk_bf16(v[j][2] * rstd2 * g[2], v[j][3] * rstd2 * g[3]); ho[64 * j] = w; }
    }
}

__device__ __forceinline__ void attn_wave_item(const bf16_t* Z, const bf16_t* VT, const float* rpb, bf16_t* YC, int b, int h, int r, int j, int lane) {
    const int fr = lane & 15, fq = lane >> 4;
    const int rs = min(max(r - 4, 0), 24);
    const int kc0 = (j == 0) ? 0 : (j == 1) ? 8 : (j == 2) ? 24 : 32;
    const int w = j * 16 + fr;
    const int tokq = b * SEQ + r * 64 + w;
    const int cs = min(max(w - 8, 0), 48);
    bf16x8 qf[4];
    { const bf16_t* qp = Z + (size_t)tokq * DIN + OFF_Q + h * 128 + 32 * fq;
#pragma unroll
      for (int s = 0; s < 4; ++s) qf[s] = *(const bf16x8*)(qp + 8 * s); }
    f32x4 sacc[8][2];
    const int kcl = 8 * (fr >> 2) + (fr & 3);
#pragma unroll
    for (int i = 0; i < 8; ++i)
#pragma unroll
        for (int hf = 0; hf < 2; ++hf) {
            const int tok = b * SEQ + (rs + i) * 64 + kc0 + kcl + 4 * hf;
            const bf16_t* kp = Z + (size_t)tok * DIN + OFF_K + h * 128 + 32 * fq;
            f32x4 a = (f32x4){0.f, 0.f, 0.f, 0.f};
#pragma unroll
            for (int s = 0; s < 4; ++s) a = __builtin_amdgcn_mfma_f32_16x16x32_bf16(*(const bf16x8*)(kp + 8 * s), qf[s], a, 0, 0, 0);
            sacc[i][hf] = a;
        }
    const float scale = 0.08838834764831845f;
    const float* rp = rpb + h * (15 * 31);
    float mx = -1e30f;
#pragma unroll
    for (int i = 0; i < 8; ++i) {
        const int dr = rs + i - r + 7;
#pragma unroll
        for (int hf = 0; hf < 2; ++hf)
#pragma unroll
            for (int rg = 0; rg < 4; ++rg) {
                const int kc = kc0 + 8 * fq + 4 * hf + rg;
                const bool valid = (kc >= cs) && (kc < cs + 16);
                const int dc = min(max(kc - w + 15, 0), 30);
                const float sv = sacc[i][hf][rg] * scale + rp[dr * 31 + dc];
                sacc[i][hf][rg] = valid ? sv : -1e30f;
                mx = fmaxf(mx, sacc[i][hf][rg]);
            }
    }
    mx = fmaxf(mx, __shfl_xor(mx, 16)); mx = fmaxf(mx, __shfl_xor(mx, 32));
    float sum = 0.f;
    bf16x8 pf[8];
#pragma unroll
    for (int i = 0; i < 8; ++i) {
        float pv[8];
#pragma unroll
        for (int hf = 0; hf < 2; ++hf)
#pragma unroll
            for (int rg = 0; rg < 4; ++rg) { const float sv = sacc[i][hf][rg]; const float pe = (sv > -1e29f) ? __expf(sv - mx) : 0.f; pv[hf * 4 + rg] = pe; sum += pe; }
        u32x4 pk; pk.x = cvt_pk_bf16(pv[0], pv[1]); pk.y = cvt_pk_bf16(pv[2], pv[3]); pk.z = cvt_pk_bf16(pv[4], pv[5]); pk.w = cvt_pk_bf16(pv[6], pv[7]);
        pf[i] = __builtin_bit_cast(bf16x8, pk);
    }
    sum += __shfl_xor(sum, 16); sum += __shfl_xor(sum, 32);
    const float inv = 1.0f / sum;
    f32x4 oacc[8];
#pragma unroll
    for (int dt = 0; dt < 8; ++dt) oacc[dt] = (f32x4){0.f, 0.f, 0.f, 0.f};
#pragma unroll
    for (int i = 0; i < 8; ++i) {
        const bf16_t* vp = VT + (size_t)(h * 128 + fr) * MTOK + b * SEQ + (rs + i) * 64 + kc0 + 8 * fq;
#pragma unroll
        for (int dt = 0; dt < 8; ++dt) oacc[dt] = __builtin_amdgcn_mfma_f32_16x16x32_bf16(*(const bf16x8*)(vp + (size_t)(16 * dt) * MTOK), pf[i], oacc[dt], 0, 0, 0);
    }
    const bf16_t* gp = Z + (size_t)tokq * DIN + OFF_GA + h * 128 + 4 * fq;
    bf16_t* op = YC + (size_t)tokq * DMIX + h * 128 + 4 * fq;
#pragma unroll
    for (int dt = 0; dt < 8; ++dt) {
        const u32x2 gw = *(const u32x2*)(gp + 16 * dt);
        const float g0 = silu_f(bf_lo(gw.x)), g1 = silu_f(bf_hi(gw.x)), g2 = silu_f(bf_lo(gw.y)), g3 = silu_f(bf_hi(gw.y));
        u32x2 o; o.x = cvt_pk_bf16(oacc[dt][0] * inv * g0, oacc[dt][1] * inv * g1); o.y = cvt_pk_bf16(oacc[dt][2] * inv * g2, oacc[dt][3] * inv * g3);
        *(u32x2*)(op + 16 * dt) = o;
    }
}

constexpr int SGU_ROWB = 272;
__device__ __forceinline__ void sgu_item(LAS unsigned char* lds, const bf16_t* Z, const bf16_t* SGW, const float* ln_g, const float* ln_b, const float* b_s, bf16_t* YC, int item, int wid, int lane) {
    const int g = item & 3, bn = item >> 2;
    const int tk0 = bn * 128;
    const int fr = lane & 15, fq = lane >> 4;
    float lg[8], lb[8];
    { const f32x4* gp4 = (const f32x4*)(ln_g + 8 * lane); const f32x4* bp4 = (const f32x4*)(ln_b + 8 * lane); const f32x4 a0 = gp4[0], a1 = gp4[1], c0 = bp4[0], c1 = bp4[1];
      lg[0] = a0[0]; lg[1] = a0[1]; lg[2] = a0[2]; lg[3] = a0[3]; lg[4] = a1[0]; lg[5] = a1[1]; lg[6] = a1[2]; lg[7] = a1[3];
      lb[0] = c0[0]; lb[1] = c0[1]; lb[2] = c0[2]; lb[3] = c0[3]; lb[4] = c1[0]; lb[5] = c1[1]; lb[6] = c1[2]; lb[7] = c1[3]; }
    for (int it = 0; it < 16; ++it) {
        const int s = 16 * wid + it;
        const u32x4 raw = *(const u32x4*)(Z + (size_t)(tk0 + s) * DIN + OFF_VB + 8 * lane);
        float x[8]; x[0] = bf_lo(raw.x); x[1] = bf_hi(raw.x); x[2] = bf_lo(raw.y); x[3] = bf_hi(raw.y); x[4] = bf_lo(raw.z); x[5] = bf_hi(raw.z); x[6] = bf_lo(raw.w); x[7] = bf_hi(raw.w);
        float sm = 0.f;
#pragma unroll
        for (int e = 0; e < 8; ++e) { x[e] = gelu_f(x[e]); sm += x[e]; }
        const float mean = wave_sum(sm) * (1.0f / 512.0f);
        float sq = 0.f;
#pragma unroll
        for (int e = 0; e < 8; ++e) { x[e] -= mean; sq += x[e] * x[e]; }
        const float rstd = 1.0f / sqrtf(wave_sum(sq) * (1.0f / 512.0f) + EPS);
        if ((lane >> 4) == g) {
            const int cl = 8 * (lane & 15);
#pragma unroll
            for (int e = 0; e < 8; ++e) { const float y = x[e] * rstd * lg[e] + lb[e]; *(LAS bf16_t*)(lds + (cl + e) * SGU_ROWB + s * 2) = (bf16_t)(cvt_pk_bf16(y, 0.f) & 0xffffu); }
        }
    }
    __syncthreads();
    bf16x8 wf[4];
    { const bf16_t* wp = SGW + (size_t)(g * 128 + 16 * wid + fr) * 128 + 8 * fq;
#pragma unroll
      for (int ks = 0; ks < 4; ++ks) wf[ks] = *(const bf16x8*)(wp + 32 * ks); }
    f32x4 acc[8];
#pragma unroll
    for (int ct = 0; ct < 8; ++ct) {
        f32x4 a = (f32x4){0.f, 0.f, 0.f, 0.f};
#pragma unroll
        for (int ks = 0; ks < 4; ++ks) { const bf16x8 vf = *(const LAS bf16x8*)(lds + (16 * ct + fr) * SGU_ROWB + (32 * ks + 8 * fq) * 2); a = __builtin_amdgcn_mfma_f32_16x16x32_bf16(vf, wf[ks], a, 0, 0, 0); }
        acc[ct] = a;
    }
    const int t = 16 * wid + fr, tok = tk0 + t;
    const float bs = b_s[g * 128 + t];
    const bf16_t* zr = Z + (size_t)tok * DIN + g * 128 + 4 * fq;
    bf16_t* op = YC + (size_t)tok * DMIX + 1024 + g * 128 + 4 * fq;
#pragma unroll
    for (int ct = 0; ct < 8; ++ct) {
        const u32x2 uw = *(const u32x2*)(zr + OFF_UB + 16 * ct), gw = *(const u32x2*)(zr + OFF_GB + 16 * ct);
        const float u0 = gelu_f(bf_lo(uw.x)), u1 = gelu_f(bf_hi(uw.x)), u2 = gelu_f(bf_lo(uw.y)), u3 = gelu_f(bf_hi(uw.y));
        const float g0 = silu_f(bf_lo(gw.x)), g1 = silu_f(bf_hi(gw.x)), g2 = silu_f(bf_lo(gw.y)), g3 = silu_f(bf_hi(gw.y));
        u32x2 o; o.x = cvt_pk_bf16(u0 * (acc[ct][0] + bs) * g0, u1 * (acc[ct][1] + bs) * g1); o.y = cvt_pk_bf16(u2 * (acc[ct][2] + bs) * g2, u3 * (acc[ct][3] + bs) * g3);
        *(u32x2*)(op + 16 * ct) = o;
    }
    __syncthreads();
}

constexpr int CV_G_OFF = 0, CV_G_ROWS = 62, CV_C_OFF = 63488, CV_A_ROWB = 1040;
__device__ __forceinline__ void conv_item(LAS unsigned char* lds, const bf16_t* Z, const bf16_t* PWT, const float* cw, const float* cb, const float* ln_g, const float* ln_b, const float* pwb, bf16_t* YC, int item, int tid, int wid, int lane) {
    const int b = item >> 6, t0 = (item & 63) * 32;
    const int fr = lane & 15, fq = lane >> 4;
    for (int wk = tid; wk < CV_G_ROWS * 64; wk += 512) {
        const int tt = wk >> 6, c8 = (wk & 63) * 8, p = t0 - 15 + tt;
        u32x4 o = (u32x4){0u, 0u, 0u, 0u};
        if (p >= 0 && p < SEQ) {
            const bf16_t* zr = Z + (size_t)(b * SEQ + p) * DIN + c8;
            const u32x4 av = *(const u32x4*)(zr + OFF_AC), bv = *(const u32x4*)(zr + OFF_BC);
            o.x = cvt_pk_bf16(bf_lo(av.x) * sigmoid_f(bf_lo(bv.x)), bf_hi(av.x) * sigmoid_f(bf_hi(bv.x)));
            o.y = cvt_pk_bf16(bf_lo(av.y) * sigmoid_f(bf_lo(bv.y)), bf_hi(av.y) * sigmoid_f(bf_hi(bv.y)));
            o.z = cvt_pk_bf16(bf_lo(av.z) * sigmoid_f(bf_lo(bv.z)), bf_hi(av.z) * sigmoid_f(bf_hi(bv.z)));
            o.w = cvt_pk_bf16(bf_lo(av.w) * sigmoid_f(bf_lo(bv.w)), bf_hi(av.w) * sigmoid_f(bf_hi(bv.w)));
        }
        *(LAS u32x4*)(lds + CV_G_OFF + tt * 1024 + c8 * 2) = o;
    }
    __syncthreads();
    {
        const int cp = tid & 255, th = tid >> 8;
        float w0[31], w1[31];
#pragma unroll
        for (int jj = 0; jj < 31; ++jj) { const f32x2 wv = *(const f32x2*)(cw + jj * 512 + 2 * cp); w0[jj] = wv[0]; w1[jj] = wv[1]; }
        const f32x2 bias = *(const f32x2*)(cb + 2 * cp);
        float a0[16], a1[16];
#pragma unroll
        for (int o = 0; o < 16; ++o) { a0[o] = bias[0]; a1[o] = bias[1]; }
#pragma unroll
        for (int tl = 0; tl < 46; ++tl) {
            const unsigned gv = *(const LAS unsigned*)(lds + CV_G_OFF + (16 * th + tl) * 1024 + cp * 4);
            const float h0 = bf_lo(gv), h1 = bf_hi(gv);
#pragma unroll
            for (int o = 0; o < 16; ++o) { const int jj = tl - o; if (jj >= 0 && jj <= 30) { a0[o] += h0 * w0[jj]; a1[o] += h1 * w1[jj]; } }
        }
#pragma unroll
        for (int o = 0; o < 16; ++o) *(LAS f32x2*)(lds + CV_C_OFF + (16 * th + o) * 2048 + cp * 8) = (f32x2){a0[o], a1[o]};
    }
    __syncthreads();
    {
        const f32x4 g0 = *(const f32x4*)(ln_g + 8 * lane), g1 = *(const f32x4*)(ln_g + 8 * lane + 4), b0 = *(const f32x4*)(ln_b + 8 * lane), b1 = *(const f32x4*)(ln_b + 8 * lane + 4);
#pragma unroll
        for (int q = 0; q < 4; ++q) {
            const int t = 4 * wid + q;
            f32x4 x0 = *(const LAS f32x4*)(lds + CV_C_OFF + t * 2048 + lane * 32), x1 = *(const LAS f32x4*)(lds + CV_C_OFF + t * 2048 + lane * 32 + 16);
            const float mean = wave_sum((x0[0] + x0[1]) + (x0[2] + x0[3]) + (x1[0] + x1[1]) + (x1[2] + x1[3])) * (1.0f / 512.0f);
            x0 = x0 - mean; x1 = x1 - mean;
            const float var = wave_sum((x0[0] * x0[0] + x0[1] * x0[1]) + (x0[2] * x0[2] + x0[3] * x0[3]) + (x1[0] * x1[0] + x1[1] * x1[1]) + (x1[2] * x1[2] + x1[3] * x1[3])) * (1.0f / 512.0f);
            const float rstd = 1.0f / sqrtf(var + EPS);
            const f32x4 y0 = x0 * rstd * g0 + b0, y1 = x1 * rstd * g1 + b1;
            u32x4 o; o.x = cvt_pk_bf16(silu_f(y0[0]), silu_f(y0[1])); o.y = cvt_pk_bf16(silu_f(y0[2]), silu_f(y0[3])); o.z = cvt_pk_bf16(silu_f(y1[0]), silu_f(y1[1])); o.w = cvt_pk_bf16(silu_f(y1[2]), silu_f(y1[3]));
            *(LAS u32x4*)(lds + t * CV_A_ROWB + lane * 16) = o;
        }
    }
    __syncthreads();
    {
        f32x4 acc[4][2];
#pragma unroll
        for (int nt = 0; nt < 4; ++nt) { acc[nt][0] = (f32x4){0.f, 0.f, 0.f, 0.f}; acc[nt][1] = (f32x4){0.f, 0.f, 0.f, 0.f}; }
        const bf16_t* pw = PWT + (size_t)(64 * wid + fr) * 512 + 8 * fq;
#pragma unroll 4
        for (int ks = 0; ks < 16; ++ks) {
            bf16x8 af[2];
#pragma unroll
            for (int tt = 0; tt < 2; ++tt) af[tt] = *(const LAS bf16x8*)(lds + (16 * tt + fr) * CV_A_ROWB + (32 * ks + 8 * fq) * 2);
#pragma unroll
            for (int nt = 0; nt < 4; ++nt) { const bf16x8 pf = *(const bf16x8*)(pw + (size_t)(16 * nt) * 512 + 32 * ks);
                acc[nt][0] = __builtin_amdgcn_mfma_f32_16x16x32_bf16(pf, af[0], acc[nt][0], 0, 0, 0);
                acc[nt][1] = __builtin_amdgcn_mfma_f32_16x16x32_bf16(pf, af[1], acc[nt][1], 0, 0, 0); }
        }
#pragma unroll
        for (int tt = 0; tt < 2; ++tt) {
            const int tok = b * SEQ + t0 + 16 * tt + fr;
#pragma unroll
            for (int nt = 0; nt < 4; ++nt) {
                const int n4 = 64 * wid + 16 * nt + 4 * fq;
                const f32x4 pb = *(const f32x4*)(pwb + n4);
                const u32x2 gw = *(const u32x2*)(Z + (size_t)tok * DIN + OFF_GC + n4);
                const float g0 = silu_f(bf_lo(gw.x)), g1 = silu_f(bf_hi(gw.x)), g2 = silu_f(bf_lo(gw.y)), g3 = silu_f(bf_hi(gw.y));
                u32x2 o; o.x = cvt_pk_bf16((acc[nt][tt][0] + pb[0]) * g0, (acc[nt][tt][1] + pb[1]) * g1); o.y = cvt_pk_bf16((acc[nt][tt][2] + pb[2]) * g2, (acc[nt][tt][3] + pb[3]) * g3);
                *(u32x2*)(YC + (size_t)tok * DMIX + 1536 + n4) = o;
            }
        }
    }
    __syncthreads();
}

struct Params { const float* in[16]; float* out; unsigned char* ws; };

__global__ void __launch_bounds__(512, 2) fwd_megakernel(Params p) {
    extern __shared__ __attribute__((aligned(16))) unsigned char lds_raw[];
    cg::grid_group grid = cg::this_grid();
    LAS unsigned char* lds = (LAS unsigned char*)lds_raw;
    const int G = gridDim.x, bx = blockIdx.x, NGW = G * 8;
#define FRESH_IDS() int tid = threadIdx.x; asm volatile("" : "+v"(tid)); const int lane = tid & 63, wid = __builtin_amdgcn_readfirstlane(tid >> 6); const int gw = bx * 8 + wid; (void)gw; (void)lane
    unsigned char* ws = p.ws;
    const float* x = p.in[0]; const float* pre_g = p.in[1]; const float* w_in = p.in[2]; const float* rpb = p.in[3];
    const float* sgu_ln_g = p.in[4]; const float* sgu_ln_b = p.in[5]; const float* sgu_w = p.in[6]; const float* sgu_b = p.in[7];
    const float* conv_w = p.in[8]; const float* conv_b = p.in[9]; const float* conv_ln_g = p.in[10]; const float* conv_ln_b = p.in[11];
    const float* conv_pw_w = p.in[12]; const float* conv_pw_b = p.in[13]; const float* w_out = p.in[14]; const float* post_g = p.in[15];
    bf16_t* WinT = (bf16_t*)(ws + WS_WIN); bf16_t* WoutT = (bf16_t*)(ws + WS_WOUT); bf16_t* PwT = (bf16_t*)(ws + WS_PW); bf16_t* SgW = (bf16_t*)(ws + WS_SGW);
    float* SSQ = (float*)(ws + WS_SSQ); bf16_t* H = (bf16_t*)(ws + WS_H); bf16_t* Z = (bf16_t*)(ws + WS_Z); bf16_t* VT = (bf16_t*)(ws + WS_VT);
    bf16_t* YC = (bf16_t*)(ws + WS_YC); float* Y = (float*)(ws + WS_Y); float* X1 = (float*)(ws + WS_X1);

    {
        FRESH_IDS();
        LAS float* scr = (LAS float*)(lds + wid * 16384);
        constexpr int I_IN = (DM / 64) * (DIN / 32), I_OUT = (DMIX / 64) * (DM / 32), I_PW = (512 / 64) * (512 / 32);
        constexpr int NITEMS = 2 * (I_IN + I_OUT + I_PW);
        for (int it = gw; it < NITEMS; it += NGW) {
            int r = it;
            if (r < 2 * I_IN) { const int l = r / I_IN; p0_transpose_item(w_in + (size_t)l * DM * DIN, DM, DIN, WinT + (size_t)l * DIN * DM, scr, r % I_IN, lane); continue; } r -= 2 * I_IN;
            if (r < 2 * I_OUT) { const int l = r / I_OUT; p0_transpose_item(w_out + (size_t)l * DMIX * DM, DMIX, DM, WoutT + (size_t)l * DM * DMIX, scr, r % I_OUT, lane); continue; } r -= 2 * I_OUT;
            { const int l = r / I_PW; p0_transpose_item(conv_pw_w + (size_t)l * 512 * 512, 512, 512, PwT + (size_t)l * 512 * 512, scr, r % I_PW, lane); }
        }
        for (int i = gw * 64 + lane; i < 2 * 4 * 128 * 128 / 2; i += NGW * 64) { const f32x2 v = *(const f32x2*)(sgu_w + 2 * (size_t)i); ((unsigned*)SgW)[i] = cvt_pk_bf16(v[0], v[1]); }
        for (int m = gw; m < MTOK; m += NGW) row_update<false, false, true>(x + (size_t)m * DM, nullptr, nullptr, nullptr, pre_g, nullptr, H + (size_t)m * DM, lane);
    }
    grid.sync();

#pragma unroll 1
    for (int l = 0; l < DEPTH; ++l) {
        const float* xin = (l == 0) ? x : X1;
        float* xout = (l == DEPTH - 1) ? p.out : X1;
        {
            const bf16_t* W = WinT + (size_t)l * DIN * DM;
            { pg8::Gemm g{H, W, MTOK, DIN - 1024, DM}; pg8::StaticOrder S; S.init(MTOK, DIN - 1024, G, bx, 8, 4); pg8::EpiBf16 E{Z, DIN};
              pg8::gemm_phase<pg8::EpiBf16, pg8::StaticOrder>(lds, g, S, E); }
            { pg8::Gemm g{W + (size_t)OFF_V * DM, H, 1024, MTOK, DM}; pg8::StaticOrder S; S.init(1024, MTOK, G, bx, 1 << 30, 0); pg8::EpiBf16 E{VT, MTOK};
              pg8::gemm_phase<pg8::EpiBf16, pg8::StaticOrder>(lds, g, S, E); }
        }
        grid.sync();
        {
            { FRESH_IDS();
            for (int it = bx; it < 256; it += G)
                conv_item(lds, Z, PwT + (size_t)l * 512 * 512, conv_w + (size_t)l * 31 * 512, conv_b + l * 512, conv_ln_g + l * 512, conv_ln_b + l * 512, conv_pw_b + l * 512, YC, it, tid, wid, lane); }
            { FRESH_IDS();
            for (int it = bx; it < 256; it += G)
                sgu_item(lds, Z, SgW + (size_t)l * 4 * 128 * 128, sgu_ln_g + l * 512, sgu_ln_b + l * 512, sgu_b + l * 512, YC, it, wid, lane); }
            { FRESH_IDS();
            for (int wi = gw; wi < NB * 8 * 32 * 4; wi += NGW) {
                const int j = wi & 3, r = (wi >> 2) & 31, h = (wi >> 7) & 7, b = wi >> 10;
                attn_wave_item(Z, VT, rpb + (size_t)l * 8 * 15 * 31, YC, b, h, r, j, lane);
            } }
        }
        grid.sync();
        {
            pg8::Gemm g{YC, WoutT + (size_t)l * DM * DMIX, MTOK, DM, DMIX}; pg8::StaticOrder S; S.init(MTOK, DM, G, bx, 1 << 30, 0); pg8::EpiF32Ssq E{Y, DM, SSQ};
            pg8::gemm_phase<pg8::EpiF32Ssq, pg8::StaticOrder>(lds, g, S, E);
        }
        grid.sync();
        if (l == 0) {
            FRESH_IDS();
            for (int m = gw; m < MTOK; m += NGW)
                row_update<true, true, true>(xin + (size_t)m * DM, Y + (size_t)m * DM, SSQ + (size_t)m * 32, post_g + l * DM, pre_g + (l + 1) * DM, xout + (size_t)m * DM, H + (size_t)m * DM, lane);
            grid.sync();
        } else {
            FRESH_IDS();
            for (int m = gw; m < MTOK; m += NGW)
                row_update<true, true, false>(xin + (size_t)m * DM, Y + (size_t)m * DM, SSQ + (size_t)m * 32, post_g + l * DM, nullptr, xout + (size_t)m * DM, nullptr, lane);
        }
    }
}

extern "C" void kernel_launch(void* const* d_in, const int* in_sizes, int n_in, void* d_out, int out_size, void* d_ws, size_t ws_size, hipStream_t stream) {
    static int grid_blocks = 0;
    if (grid_blocks == 0) {
        if (n_in != 16 || ws_size < WS_END) { fprintf(stderr, "kernel_launch: unexpected n_in %d / ws_size %zu\n", n_in, ws_size); grid_blocks = -1; return; }
        int dev = 0, cus = 0, per_cu = 0;
        hipGetDevice(&dev);
        hipDeviceGetAttribute(&cus, hipDeviceAttributeMultiprocessorCount, dev);
        if (hipFuncSetAttribute((const void*)fwd_megakernel, hipFuncAttributeMaxDynamicSharedMemorySize, LDS_BYTES) != hipSuccess) fprintf(stderr, "kernel_launch: hipFuncSetAttribute failed\n");
        if (hipOccupancyMaxActiveBlocksPerMultiprocessor(&per_cu, (const void*)fwd_megakernel, 512, LDS_BYTES) != hipSuccess || per_cu < 1) { fprintf(stderr, "kernel_launch: occupancy query says %d\n", per_cu); per_cu = 1; }
        (void)hipGetLastError();
        grid_blocks = cus * 1;
    }
    if (grid_blocks < 0) return;
    Params p{};
    for (int i = 0; i < 16; ++i) p.in[i] = (const float*)d_in[i];
    p.out = (float*)d_out; p.ws = (unsigned char*)d_ws;
    void* args[] = {&p};
    hipError_t e = hipLaunchCooperativeKernel((const void*)fwd_megakernel, dim3(grid_blocks), dim3(512), args, LDS_BYTES, stream);
    if (e != hipSuccess) fprintf(stderr, "cooperative launch failed: %s (grid %d)\n", hipGetErrorString(e), grid_blocks);
}
```

```cpp
#include <hip/hip_runtime.h>
#include <hip/hip_cooperative_groups.h>
#include <cstdio>
namespace cg = cooperative_groups;

#define LAS __attribute__((address_space(3)))
typedef unsigned short bf16_t;
typedef short bf16x8 __attribute__((ext_vector_type(8)));
typedef float f32x4 __attribute__((ext_vector_type(4)));
typedef float f32x2 __attribute__((ext_vector_type(2)));
typedef unsigned u32x4 __attribute__((ext_vector_type(4)));
typedef unsigned u32x2 __attribute__((ext_vector_type(2)));

constexpr int DM = 2048, NB = 4, SEQ = 2048, MTOK = NB * SEQ, DEPTH = 2;
constexpr int DIN = 7168, DMIX = 2048;
constexpr int OFF_Q = 0, OFF_K = 1024, OFF_V = 2048, OFF_GA = 3072, OFF_UB = 4096, OFF_VB = 4608, OFF_GB = 5120, OFF_AC = 5632, OFF_BC = 6144, OFF_GC = 6656;
constexpr float EPS = 1e-6f;

constexpr size_t MiB = 1u << 20;
constexpr size_t WS_WIN = 0;
constexpr size_t WS_WOUT = 56 * MiB;
constexpr size_t WS_PW = 72 * MiB;
constexpr size_t WS_SGW = 73 * MiB;
constexpr size_t WS_SSQ = 74 * MiB;
constexpr size_t WS_CTL = 75 * MiB;
constexpr size_t CTL_BYTES = 16384;
constexpr size_t WS_H = 76 * MiB;
constexpr size_t WS_Z = 108 * MiB;
constexpr size_t WS_VT = 220 * MiB;
constexpr size_t WS_YC = 236 * MiB;
constexpr size_t WS_Y = 268 * MiB;
constexpr size_t WS_X1 = 332 * MiB;
constexpr size_t WS_END = 396 * MiB;

constexpr int LDS_BYTES = 147456;

__device__ __forceinline__ unsigned cvt_pk_bf16(float lo, float hi) { unsigned r; asm volatile("v_cvt_pk_bf16_f32 %0, %1, %2" : "=v"(r) : "v"(lo), "v"(hi)); return r; }
__device__ __forceinline__ float bf_lo(unsigned w) { return __uint_as_float(w << 16); }
__device__ __forceinline__ float bf_hi(unsigned w) { return __uint_as_float(w & 0xffff0000u); }
__device__ __forceinline__ float wave_sum(float v) {
#pragma unroll
    for (int o = 1; o < 64; o <<= 1) v += __shfl_xor(v, o);
    return v;
}
__device__ __forceinline__ float gelu_f(float v) { return 0.5f * v * (1.0f + erff(v * 0.70710678118f)); }
__device__ __forceinline__ float sigmoid_f(float v) { return 1.0f / (1.0f + __expf(-v)); }
__device__ __forceinline__ float silu_f(float v) { return v / (1.0f + __expf(-v)); }
#define LDS_WAIT() asm volatile("s_waitcnt lgkmcnt(0)" ::: "memory")

namespace pg8 {
constexpr int BM = 256, BK = 64, HALF = 128, HTB = HALF * BK * 2, STAGE_BYTES = 8 * HTB, NXCD = 8, WGM = 8;
__device__ __forceinline__ int lds_byte(int r, int c) { const int st = (r >> 4) * 2 + (c >> 5), rr = r & 15, cc = c & 31, ob = rr * 64 + cc * 2; return st * 1024 + (ob ^ (((ob >> 9) & 1) << 5)); }
__device__ __forceinline__ void stage_rc(int b, int& R, int& C) { const int st = b / 1024, sb = b % 1024, swz = sb ^ (((sb >> 9) & 1) << 5); R = (st >> 1) * 16 + swz / 64; C = (st & 1) * 32 + (swz % 64) / 2; }
__device__ __forceinline__ int perm32(int rho) { const int n = rho >> 4, i = rho & 15; return 8 * (i >> 2) + 4 * n + (i & 3); }

struct Unit { int pm, pn; };
struct Gemm { const bf16_t* A; const bf16_t* Bt; int M, N, K; };

struct StaticOrder {
    int nM, nN, nwg, G, c, skip_from, skip;
    __device__ void init(int M, int N, int G_, int c_, int skip_from_, int skip_) { nM = M / BM; nN = N / BM; nwg = nM * nN; G = G_; c = c_; skip_from = skip_from_; skip = skip_; }
    __device__ bool next(int i, Unit& u) const {
        const long L = (long)i * G + c; if (L >= nwg) return false;
        int wgid = (int)L; { const int q = nwg / NXCD, r = nwg % NXCD, xcd = wgid % NXCD, off = wgid / NXCD; wgid = (xcd < r ? xcd * (q + 1) : r * (q + 1) + (xcd - r) * q) + off; }
        const int nig = WGM * nN, gid = wgid / nig, fm = gid * WGM, gsz = (nM - fm) < WGM ? (nM - fm) : WGM;
        u.pm = fm + ((wgid % nig) % gsz); u.pn = (wgid % nig) / gsz;
        if (u.pn >= skip_from) u.pn += skip;
        return true;
    }
    __device__ __forceinline__ void a_ready(const Unit&) const {}
    __device__ __forceinline__ void done(const Unit&) const {}
};

struct EpiBf16 {
    static constexpr bool PERM = true;
    bf16_t* O; int ldc;
    __device__ __forceinline__ void operator()(const f32x4 (&acc)[2][2][4][2], const Unit& u, int wr, int wc, int fr, int fq) const {
        const int row0 = u.pm * BM + wr * 64 + fr; const int col0 = u.pn * BM + wc * 32 + 8 * fq;
#pragma unroll
        for (int ai = 0; ai < 2; ++ai)
#pragma unroll
            for (int m = 0; m < 4; ++m) { bf16_t* rowp = O + (size_t)(row0 + ai * HALF + m * 16) * ldc + col0;
#pragma unroll
                for (int bj = 0; bj < 2; ++bj) { const f32x4 v0 = acc[ai][bj][m][0], v1 = acc[ai][bj][m][1];
                    u32x4 w; w.x = cvt_pk_bf16(v0[0], v0[1]); w.y = cvt_pk_bf16(v0[2], v0[3]); w.z = cvt_pk_bf16(v1[0], v1[1]); w.w = cvt_pk_bf16(v1[2], v1[3]);
                    *(u32x4*)(rowp + bj * HALF) = w; } }
    }
};
struct EpiF32Ssq {
    static constexpr bool PERM = false;
    float* C; int ldc; float* ssq;
    __device__ __forceinline__ void operator()(const f32x4 (&acc)[2][2][4][2], const Unit& u, int wr, int wc, int fr, int fq) const {
        const int row0 = u.pm * BM + wr * 64 + fr, col0 = u.pn * BM + wc * 32 + 4 * fq;
#pragma unroll
        for (int ai = 0; ai < 2; ++ai)
#pragma unroll
            for (int m = 0; m < 4; ++m) { const int row = row0 + ai * HALF + m * 16; float* rowp = C + (size_t)row * ldc + col0; float s = 0.f;
#pragma unroll
                for (int bj = 0; bj < 2; ++bj)
#pragma unroll
                    for (int n = 0; n < 2; ++n) { const f32x4 v = acc[ai][bj][m][n]; *(f32x4*)(rowp + bj * HALF + n * 16) = v; s += (v[0] * v[0] + v[1] * v[1]) + (v[2] * v[2] + v[3] * v[3]); }
                s += __shfl_xor(s, 16); s += __shfl_xor(s, 32);
                if (fq == 0) ssq[(size_t)row * 32 + u.pn * 4 + wc] = s; }
    }
};

template <class Epi, class Sched>
__device__ __forceinline__ void gemm_phase(LAS unsigned char* lds, const Gemm g, const Sched& S, const Epi& E) {
    int tid = threadIdx.x; asm volatile("" : "+v"(tid));
    const int wid = __builtin_amdgcn_readfirstlane(tid >> 6), lane = tid & 63, wr = wid >> 2, wc = wid & 3, fr = lane & 15, fq = lane >> 4;
    const int K = g.K, nt = K / BK;
    unsigned voffA[2], voffB[2];
#pragma unroll
    for (int i = 0; i < 2; ++i) { int R, C; stage_rc(tid * 16 + i * 8192, R, C); const int Rb = Epi::PERM ? ((R & ~31) + perm32(R & 31)) : R;
        voffA[i] = (unsigned)(R * K + C) * 2u; voffB[i] = (unsigned)(Rb * K + C) * 2u; }
    const size_t kstep = (size_t)(BK * 2);
    const size_t hstep = (size_t)HALF * K * 2;
    const size_t tstep = 2 * hstep;
    const unsigned ldsw = (unsigned)wid * 1024u;
    const int aoff = lds_byte(wr * 64 + fr, fq * 8), boff = lds_byte(wc * 32 + fr, fq * 8);
#define PG8_SA(b, h) (((b) * 2 + (h)) * HTB)
#define PG8_SB(b, h) ((4 + (b) * 2 + (h)) * HTB)
#define PG8_STAGE(bufoff, gbase, voff) do { _Pragma("unroll") for (int _i = 0; _i < 2; ++_i) \
        __builtin_amdgcn_global_load_lds((const unsigned*)((const char*)(gbase) + (voff)[_i]), (LAS unsigned*)(lds + (bufoff) + ldsw + _i * 8192), 16, 0, 0); } while (0)
#define PG8_LDA(dst, b, h) do { _Pragma("unroll") for (int m = 0; m < 4; ++m) _Pragma("unroll") for (int k = 0; k < 2; ++k) dst[m][k] = *(const LAS bf16x8*)(lds + PG8_SA(b, h) + aoff + m * 2048 + k * 1024); } while (0)
#define PG8_LDB(dst, b, h) do { _Pragma("unroll") for (int n = 0; n < 2; ++n) _Pragma("unroll") for (int k = 0; k < 2; ++k) dst[n][k] = *(const LAS bf16x8*)(lds + PG8_SB(b, h) + boff + n * 2048 + k * 1024); } while (0)
#define PG8_MMA(ai, bj, At, Bt) do { __builtin_amdgcn_s_setprio(1); _Pragma("unroll") for (int m = 0; m < 4; ++m) _Pragma("unroll") for (int n = 0; n < 2; ++n) _Pragma("unroll") for (int k = 0; k < 2; ++k) \
        acc[ai][bj][m][n] = __builtin_amdgcn_mfma_f32_16x16x32_bf16(Bt[n][k], At[m][k], acc[ai][bj][m][n], 0, 0, 0); __builtin_amdgcn_s_setprio(0); } while (0)
#define PG8_WAIT_V(n) asm volatile("s_waitcnt vmcnt(" #n ")" ::: "memory")
#define PG8_WAIT_L(n) asm volatile("s_waitcnt lgkmcnt(" #n ")" ::: "memory")
#define PG8_BAR __builtin_amdgcn_s_barrier()
#define PG8_SCHED __builtin_amdgcn_sched_barrier(0)
    Unit cur, nxt; int ui = 0;
    if (!S.next(0, cur)) return;
    f32x4 acc[2][2][4][2];
#pragma unroll
    for (int a = 0; a < 2; ++a)
#pragma unroll
        for (int b = 0; b < 2; ++b)
#pragma unroll
            for (int m = 0; m < 4; ++m)
#pragma unroll
                for (int n = 0; n < 2; ++n) acc[a][b][m][n] = (f32x4){0.f, 0.f, 0.f, 0.f};
    bf16x8 At[4][2], B0[2][2], B1[2][2];
    const char* cA = (const char*)g.A + (size_t)cur.pm * tstep; const char* cB = (const char*)g.Bt + (size_t)cur.pn * tstep;
    S.a_ready(cur);
    PG8_STAGE(PG8_SB(0, 0), cB, voffB); PG8_STAGE(PG8_SA(0, 0), cA, voffA); PG8_STAGE(PG8_SB(0, 1), cB + hstep, voffB); PG8_STAGE(PG8_SA(0, 1), cA + hstep, voffA);
    if (wr == 1) PG8_BAR;
    PG8_WAIT_V(4); PG8_BAR;
    PG8_STAGE(PG8_SB(1, 0), cB + kstep, voffB); PG8_STAGE(PG8_SA(1, 0), cA + kstep, voffA); PG8_STAGE(PG8_SB(1, 1), cB + hstep + kstep, voffB);
    PG8_WAIT_V(6); PG8_BAR;
    for (;;) {
        const bool has_next = S.next(ui + 1, nxt);
        const char* nA = has_next ? (const char*)g.A + (size_t)nxt.pm * tstep : cA; const char* nB = has_next ? (const char*)g.Bt + (size_t)nxt.pn * tstep : cB;
        for (int t = 0; t < nt; t += 2) {
            const bool last = (t == nt - 2);
            const char* a1 = cA + (size_t)(t + 1) * kstep;
            const char* a2 = last ? nA : cA + (size_t)(t + 2) * kstep; const char* b2 = last ? nB : cB + (size_t)(t + 2) * kstep;
            const char* a3 = a2 + kstep; const char* b3 = b2 + kstep;
            if (last && has_next) S.a_ready(nxt);
            PG8_LDB(B0, 0, 0); PG8_SCHED; PG8_LDA(At, 0, 0); PG8_STAGE(PG8_SA(1, 1), a1 + hstep, voffA);
            PG8_WAIT_L(8); PG8_BAR; PG8_WAIT_L(0); PG8_MMA(0, 0, At, B0); PG8_BAR; PG8_SCHED;
            PG8_LDB(B1, 0, 1); PG8_STAGE(PG8_SB(0, 0), b2, voffB);
            PG8_BAR; PG8_WAIT_L(0); PG8_MMA(0, 1, At, B1); PG8_BAR;
            PG8_LDA(At, 0, 1); PG8_STAGE(PG8_SA(0, 0), a2, voffA);
            PG8_BAR; PG8_WAIT_L(0); PG8_MMA(1, 0, At, B0); PG8_BAR; PG8_SCHED;
            PG8_STAGE(PG8_SB(0, 1), b2 + hstep, voffB);
            PG8_WAIT_V(6); PG8_BAR; PG8_MMA(1, 1, At, B1); PG8_BAR;
            PG8_LDB(B0, 1, 0); PG8_SCHED; PG8_LDA(At, 1, 0); PG8_STAGE(PG8_SA(0, 1), a2 + hstep, voffA);
            PG8_WAIT_L(8); PG8_BAR; PG8_WAIT_L(0); PG8_MMA(0, 0, At, B0); PG8_BAR; PG8_SCHED;
            PG8_LDB(B1, 1, 1); PG8_STAGE(PG8_SB(1, 0), b3, voffB);
            PG8_BAR; PG8_WAIT_L(0); PG8_MMA(0, 1, At, B1); PG8_BAR;
            PG8_LDA(At, 1, 1); PG8_STAGE(PG8_SA(1, 0), a3, voffA);
            PG8_BAR; PG8_WAIT_L(0); PG8_MMA(1, 0, At, B0); PG8_BAR; PG8_SCHED;
            PG8_STAGE(PG8_SB(1, 1), b3 + hstep, voffB);
            PG8_WAIT_V(6); PG8_BAR; PG8_MMA(1, 1, At, B1); PG8_BAR;
        }
        E(acc, cur, wr, wc, fr, fq); S.done(cur);
        if (!has_next) break;
#pragma unroll
        for (int a = 0; a < 2; ++a)
#pragma unroll
            for (int b = 0; b < 2; ++b)
#pragma unroll
                for (int m = 0; m < 4; ++m)
#pragma unroll
                    for (int n = 0; n < 2; ++n) acc[a][b][m][n] = (f32x4){0.f, 0.f, 0.f, 0.f};
        cur = nxt; cA = nA; cB = nB; ++ui;
    }
    PG8_WAIT_V(0);
    if (wr == 0) PG8_BAR;
    PG8_BAR;
#undef PG8_SA
#undef PG8_SB
#undef PG8_STAGE
#undef PG8_LDA
#undef PG8_LDB
#undef PG8_MMA
#undef PG8_WAIT_V
#undef PG8_WAIT_L
#undef PG8_BAR
#undef PG8_SCHED
}
}

__device__ __forceinline__ void p0_transpose_item(const float* W, int K, int N, bf16_t* WT, LAS float* scr, int item, int lane) {
    const int nblk = N / 32, kb = item / nblk, nb = item % nblk, k0 = 64 * kb, n0 = 32 * nb;
#pragma unroll 8
    for (int i = 0; i < 32; ++i) { const int kk = 2 * i + (lane >> 5); scr[kk * 33 + (lane & 31)] = W[(size_t)(k0 + kk) * N + n0 + (lane & 31)]; }
    LDS_WAIT(); asm volatile("" ::: "memory");
    const int c = lane & 7;
#pragma unroll
    for (int j = 0; j < 4; ++j) { const int n = (lane >> 3) + 8 * j; const LAS float* s = scr + (8 * c) * 33 + n;
        u32x4 o; o.x = cvt_pk_bf16(s[0 * 33], s[1 * 33]); o.y = cvt_pk_bf16(s[2 * 33], s[3 * 33]); o.z = cvt_pk_bf16(s[4 * 33], s[5 * 33]); o.w = cvt_pk_bf16(s[6 * 33], s[7 * 33]);
        *(u32x4*)(WT + (size_t)(n0 + n) * K + k0 + 8 * c) = o; }
    LDS_WAIT(); asm volatile("" ::: "memory");
}

template <bool HAS_Y, bool WRITE_X, bool WRITE_H>
__device__ __forceinline__ void row_update(const float* xrow, const float* yrow, const float* ssq_row, const float* gpost, const float* gpre, float* xout, bf16_t* hout, int lane) {
    f32x4 v[8];
    const f32x4* xr = (const f32x4*)xrow + lane;
#pragma unroll
    for (int j = 0; j < 8; ++j) v[j] = xr[64 * j];
    if (HAS_Y) {
        float s = ssq_row[lane & 31];
#pragma unroll
        for (int o = 1; o < 32; o <<= 1) s += __shfl_xor(s, o);
        const float rstd = 1.0f / sqrtf(s * (1.0f / DM) + EPS);
        const f32x4* yr = (const f32x4*)yrow + lane; const f32x4* gp = (const f32x4*)gpost + lane;
#pragma unroll
        for (int j = 0; j < 8; ++j) { const f32x4 y = yr[64 * j], g = gp[64 * j]; v[j] = v[j] + (y * rstd) * g; }
    }
    if (WRITE_X) { f32x4* xo = (f32x4*)xout + lane;
#pragma unroll
        for (int j = 0; j < 8; ++j) xo[64 * j] = v[j]; }
    if (WRITE_H) {
        float s2 = 0.f;
#pragma unroll
        for (int j = 0; j < 8; ++j) s2 += (v[j][0] * v[j][0] + v[j][1] * v[j][1]) + (v[j][2] * v[j][2] + v[j][3] * v[j][3]);
        const float rstd2 = 1.0f / sqrtf(wave_sum(s2) * (1.0f / DM) + EPS);
        const f32x4* gq = (const f32x4*)gpre + lane; u32x2* ho = (u32x2*)hout + lane;
#pragma unroll
        for (int j = 0; j < 8; ++j) { const f32x4 g = gq[64 * j]; u32x2 w; w.x = cvt_pk_bf16(v[j][0] * rstd2 * g[0], v[j][1] * rstd2 * g[1]); w.y = cvt_pk_bf16(v[j][2] * rstd2 * g[2], v[j][3] * rstd2 * g[3]); ho[64 * j] = w; }
    }
}

__device__ __forceinline__ void attn_wave_item(const bf16_t* Z, const bf16_t* VT, const float* rpb, bf16_t* YC, int b, int h, int r, int j, int lane) {
    const int fr = lane & 15, fq = lane >> 4;
    const int rs = min(max(r - 4, 0), 24);
    const int kc0 = (j == 0) ? 0 : (j == 1) ? 8 : (j == 2) ? 24 : 32;
    const int w = j * 16 + fr;
    const int tokq = b * SEQ + r * 64 + w;
    const int cs = min(max(w - 8, 0), 48);
    bf16x8 qf[4];
    { const bf16_t* qp = Z + (size_t)tokq * DIN + OFF_Q + h * 128 + 32 * fq;
#pragma unroll
      for (int s = 0; s < 4; ++s) qf[s] = *(const bf16x8*)(qp + 8 * s); }
    f32x4 sacc[8][2];
    const int kcl = 8 * (fr >> 2) + (fr & 3);
#pragma unroll
    for (int i = 0; i < 8; ++i)
#pragma unroll
        for (int hf = 0; hf < 2; ++hf) {
            const int tok = b * SEQ + (rs + i) * 64 + kc0 + kcl + 4 * hf;
            const bf16_t* kp = Z + (size_t)tok * DIN + OFF_K + h * 128 + 32 * fq;
            f32x4 a = (f32x4){0.f, 0.f, 0.f, 0.f};
#pragma unroll
            for (int s = 0; s < 4; ++s) a = __builtin_amdgcn_mfma_f32_16x16x32_bf16(*(const bf16x8*)(kp + 8 * s), qf[s], a, 0, 0, 0);
            sacc[i][hf] = a;
        }
    const float scale = 0.08838834764831845f;
    const float* rp = rpb + h * (15 * 31);
    float mx = -1e30f;
#pragma unroll
    for (int i = 0; i < 8; ++i) {
        const int dr = rs + i - r + 7;
#pragma unroll
        for (int hf = 0; hf < 2; ++hf)
#pragma unroll
            for (int rg = 0; rg < 4; ++rg) {
                const int kc = kc0 + 8 * fq + 4 * hf + rg;
                const bool valid = (kc >= cs) && (kc < cs + 16);
                const int dc = min(max(kc - w + 15, 0), 30);
                const float sv = sacc[i][hf][rg] * scale + rp[dr * 31 + dc];
                sacc[i][hf][rg] = valid ? sv : -1e30f;
                mx = fmaxf(mx, sacc[i][hf][rg]);
            }
    }
    mx = fmaxf(mx, __shfl_xor(mx, 16)); mx = fmaxf(mx, __shfl_xor(mx, 32));
    float sum = 0.f;
    bf16x8 pf[8];
#pragma unroll
    for (int i = 0; i < 8; ++i) {
        float pv[8];
#pragma unroll
        for (int hf = 0; hf < 2; ++hf)
#pragma unroll
            for (int rg = 0; rg < 4; ++rg) { const float sv = sacc[i][hf][rg]; const float pe = (sv > -1e29f) ? __expf(sv - mx) : 0.f; pv[hf * 4 + rg] = pe; sum += pe; }
        u32x4 pk; pk.x = cvt_pk_bf16(pv[0], pv[1]); pk.y = cvt_pk_bf16(pv[2], pv[3]); pk.z = cvt_pk_bf16(pv[4], pv[5]); pk.w = cvt_pk_bf16(pv[6], pv[7]);
        pf[i] = __builtin_bit_cast(bf16x8, pk);
    }
    sum += __shfl_xor(sum, 16); sum += __shfl_xor(sum, 32);
    const float inv = 1.0f / sum;
    f32x4 oacc[8];
#pragma unroll
    for (int dt = 0; dt < 8; ++dt) oacc[dt] = (f32x4){0.f, 0.f, 0.f, 0.f};
#pragma unroll
    for (int i = 0; i < 8; ++i) {
        const bf16_t* vp = VT + (size_t)(h * 128 + fr) * MTOK + b * SEQ + (rs + i) * 64 + kc0 + 8 * fq;
#pragma unroll
        for (int dt = 0; dt < 8; ++dt) oacc[dt] = __builtin_amdgcn_mfma_f32_16x16x32_bf16(*(const bf16x8*)(vp + (size_t)(16 * dt) * MTOK), pf[i], oacc[dt], 0, 0, 0);
    }
    const bf16_t* gp = Z + (size_t)tokq * DIN + OFF_GA + h * 128 + 4 * fq;
    bf16_t* op = YC + (size_t)tokq * DMIX + h * 128 + 4 * fq;
#pragma unroll
    for (int dt = 0; dt < 8; ++dt) {
        const u32x2 gw = *(const u32x2*)(gp + 16 * dt);
        const float g0 = silu_f(bf_lo(gw.x)), g1 = silu_f(bf_hi(gw.x)), g2 = silu_f(bf_lo(gw.y)), g3 = silu_f(bf_hi(gw.y));
        u32x2 o; o.x = cvt_pk_bf16(oacc[dt][0] * inv * g0, oacc[dt][1] * inv * g1); o.y = cvt_pk_bf16(oacc[dt][2] * inv * g2, oacc[dt][3] * inv * g3);
        *(u32x2*)(op + 16 * dt) = o;
    }
}

constexpr int SGU_ROWB = 272;
__device__ __forceinline__ void sgu_item(LAS unsigned char* lds, const bf16_t* Z, const bf16_t* SGW, const float* ln_g, const float* ln_b, const float* b_s, bf16_t* YC, int item, int wid, int lane) {
    const int g = item & 3, bn = item >> 2;
    const int tk0 = bn * 128;
    const int fr = lane & 15, fq = lane >> 4;
    float lg[8], lb[8];
    { const f32x4* gp4 = (const f32x4*)(ln_g + 8 * lane); const f32x4* bp4 = (const f32x4*)(ln_b + 8 * lane); const f32x4 a0 = gp4[0], a1 = gp4[1], c0 = bp4[0], c1 = bp4[1];
      lg[0] = a0[0]; lg[1] = a0[1]; lg[2] = a0[2]; lg[3] = a0[3]; lg[4] = a1[0]; lg[5] = a1[1]; lg[6] = a1[2]; lg[7] = a1[3];
      lb[0] = c0[0]; lb[1] = c0[1]; lb[2] = c0[2]; lb[3] = c0[3]; lb[4] = c1[0]; lb[5] = c1[1]; lb[6] = c1[2]; lb[7] = c1[3]; }
    for (int it = 0; it < 16; ++it) {
        const int s = 16 * wid + it;
        const u32x4 raw = *(const u32x4*)(Z + (size_t)(tk0 + s) * DIN + OFF_VB + 8 * lane);
        float x[8]; x[0] = bf_lo(raw.x); x[1] = bf_hi(raw.x); x[2] = bf_lo(raw.y); x[3] = bf_hi(raw.y); x[4] = bf_lo(raw.z); x[5] = bf_hi(raw.z); x[6] = bf_lo(raw.w); x[7] = bf_hi(raw.w);
        float sm = 0.f;
#pragma unroll
        for (int e = 0; e < 8; ++e) { x[e] = gelu_f(x[e]); sm += x[e]; }
        const float mean = wave_sum(sm) * (1.0f / 512.0f);
        float sq = 0.f;
#pragma unroll
        for (int e = 0; e < 8; ++e) { x[e] -= mean; sq += x[e] * x[e]; }
        const float rstd = 1.0f / sqrtf(wave_sum(sq) * (1.0f / 512.0f) + EPS);
        if ((lane >> 4) == g) {
            const int cl = 8 * (lane & 15);
#pragma unroll
            for (int e = 0; e < 8; ++e) { const float y = x[e] * rstd * lg[e] + lb[e]; *(LAS bf16_t*)(lds + (cl + e) * SGU_ROWB + s * 2) = (bf16_t)(cvt_pk_bf16(y, 0.f) & 0xffffu); }
        }
    }
    __syncthreads();
    bf16x8 wf[4];
    { const bf16_t* wp = SGW + (size_t)(g * 128 + 16 * wid + fr) * 128 + 8 * fq;
#pragma unroll
      for (int ks = 0; ks < 4; ++ks) wf[ks] = *(const bf16x8*)(wp + 32 * ks); }
    f32x4 acc[8];
#pragma unroll
    for (int ct = 0; ct < 8; ++ct) {
        f32x4 a = (f32x4){0.f, 0.f, 0.f, 0.f};
#pragma unroll
        for (int ks = 0; ks < 4; ++ks) { const bf16x8 vf = *(const LAS bf16x8*)(lds + (16 * ct + fr) * SGU_ROWB + (32 * ks + 8 * fq) * 2); a = __builtin_amdgcn_mfma_f32_16x16x32_bf16(vf, wf[ks], a, 0, 0, 0); }
        acc[ct] = a;
    }
    const int t = 16 * wid + fr, tok = tk0 + t;
    const float bs = b_s[g * 128 + t];
    const bf16_t* zr = Z + (size_t)tok * DIN + g * 128 + 4 * fq;
    bf16_t* op = YC + (size_t)tok * DMIX + 1024 + g * 128 + 4 * fq;
#pragma unroll
    for (int ct = 0; ct < 8; ++ct) {
        const u32x2 uw = *(const u32x2*)(zr + OFF_UB + 16 * ct), gw = *(const u32x2*)(zr + OFF_GB + 16 * ct);
        const float u0 = gelu_f(bf_lo(uw.x)), u1 = gelu_f(bf_hi(uw.x)), u2 = gelu_f(bf_lo(uw.y)), u3 = gelu_f(bf_hi(uw.y));
        const float g0 = silu_f(bf_lo(gw.x)), g1 = silu_f(bf_hi(gw.x)), g2 = silu_f(bf_lo(gw.y)), g3 = silu_f(bf_hi(gw.y));
        u32x2 o; o.x = cvt_pk_bf16(u0 * (acc[ct][0] + bs) * g0, u1 * (acc[ct][1] + bs) * g1); o.y = cvt_pk_bf16(u2 * (acc[ct][2] + bs) * g2, u3 * (acc[ct][3] + bs) * g3);
        *(u32x2*)(op + 16 * ct) = o;
    }
    __syncthreads();
}

constexpr int CV_G_OFF = 0, CV_G_ROWS = 62, CV_C_OFF = 63488, CV_A_ROWB = 1040;
__device__ __forceinline__ void conv_item(LAS unsigned char* lds, const bf16_t* Z, const bf16_t* PWT, const float* cw, const float* cb, const float* ln_g, const float* ln_b, const float* pwb, bf16_t* YC, int item, int tid, int wid, int lane) {
    const int b = item >> 6, t0 = (item & 63) * 32;
    const int fr = lane & 15, fq = lane >> 4;
    for (int wk = tid; wk < CV_G_ROWS * 64; wk += 512) {
        const int tt = wk >> 6, c8 = (wk & 63) * 8, p = t0 - 15 + tt;
        u32x4 o = (u32x4){0u, 0u, 0u, 0u};
        if (p >= 0 && p < SEQ) {
            const bf16_t* zr = Z + (size_t)(b * SEQ + p) * DIN + c8;
            const u32x4 av = *(const u32x4*)(zr + OFF_AC), bv = *(const u32x4*)(zr + OFF_BC);
            o.x = cvt_pk_bf16(bf_lo(av.x) * sigmoid_f(bf_lo(bv.x)), bf_hi(av.x) * sigmoid_f(bf_hi(bv.x)));
            o.y = cvt_pk_bf16(bf_lo(av.y) * sigmoid_f(bf_lo(bv.y)), bf_hi(av.y) * sigmoid_f(bf_hi(bv.y)));
            o.z = cvt_pk_bf16(bf_lo(av.z) * sigmoid_f(bf_lo(bv.z)), bf_hi(av.z) * sigmoid_f(bf_hi(bv.z)));
            o.w = cvt_pk_bf16(bf_lo(av.w) * sigmoid_f(bf_lo(bv.w)), bf_hi(av.w) * sigmoid_f(bf_hi(bv.w)));
        }
        *(LAS u32x4*)(lds + CV_G_OFF + tt * 1024 + c8 * 2) = o;
    }
    __syncthreads();
    {
        const int cp = tid & 255, th = tid >> 8;
        float w0[31], w1[31];
#pragma unroll
        for (int jj = 0; jj < 31; ++jj) { const f32x2 wv = *(const f32x2*)(cw + jj * 512 + 2 * cp); w0[jj] = wv[0]; w1[jj] = wv[1]; }
        const f32x2 bias = *(const f32x2*)(cb + 2 * cp);
        float a0[16], a1[16];
#pragma unroll
        for (int o = 0; o < 16; ++o) { a0[o] = bias[0]; a1[o] = bias[1]; }
#pragma unroll
        for (int tl = 0; tl < 46; ++tl) {
            const unsigned gv = *(const LAS unsigned*)(lds + CV_G_OFF + (16 * th + tl) * 1024 + cp * 4);
            const float h0 = bf_lo(gv), h1 = bf_hi(gv);
#pragma unroll
            for (int o = 0; o < 16; ++o) { const int jj = tl - o; if (jj >= 0 && jj <= 30) { a0[o] += h0 * w0[jj]; a1[o] += h1 * w1[jj]; } }
        }
#pragma unroll
        for (int o = 0; o < 16; ++o) *(LAS f32x2*)(lds + CV_C_OFF + (16 * th + o) * 2048 + cp * 8) = (f32x2){a0[o], a1[o]};
    }
    __syncthreads();
    {
        const f32x4 g0 = *(const f32x4*)(ln_g + 8 * lane), g1 = *(const f32x4*)(ln_g + 8 * lane + 4), b0 = *(const f32x4*)(ln_b + 8 * lane), b1 = *(const f32x4*)(ln_b + 8 * lane + 4);
#pragma unroll
        for (int q = 0; q < 4; ++q) {
            const int t = 4 * wid + q;
            f32x4 x0 = *(const LAS f32x4*)(lds + CV_C_OFF + t * 2048 + lane * 32), x1 = *(const LAS f32x4*)(lds + CV_C_OFF + t * 2048 + lane * 32 + 16);
            const float mean = wave_sum((x0[0] + x0[1]) + (x0[2] + x0[3]) + (x1[0] + x1[1]) + (x1[2] + x1[3])) * (1.0f / 512.0f);
            x0 = x0 - mean; x1 = x1 - mean;
            const float var = wave_sum((x0[0] * x0[0] + x0[1] * x0[1]) + (x0[2] * x0[2] + x0[3] * x0[3]) + (x1[0] * x1[0] + x1[1] * x1[1]) + (x1[2] * x1[2] + x1[3] * x1[3])) * (1.0f / 512.0f);
            const float rstd = 1.0f / sqrtf(var + EPS);
            const f32x4 y0 = x0 * rstd * g0 + b0, y1 = x1 * rstd * g1 + b1;
            u32x4 o; o.x = cvt_pk_bf16(silu_f(y0[0]), silu_f(y0[1])); o.y = cvt_pk_bf16(silu_f(y0[2]), silu_f(y0[3])); o.z = cvt_pk_bf16(silu_f(y1[0]), silu_f(y1[1])); o.w = cvt_pk_bf16(silu_f(y1[2]), silu_f(y1[3]));
            *(LAS u32x4*)(lds + t * CV_A_ROWB + lane * 16) = o;
        }
    }
    __syncthreads();
    {
        f32x4 acc[4][2];
#pragma unroll
        for (int nt = 0; nt < 4; ++nt) { acc[nt][0] = (f32x4){0.f, 0.f, 0.f, 0.f}; acc[nt][1] = (f32x4){0.f, 0.f, 0.f, 0.f}; }
        const bf16_t* pw = PWT + (size_t)(64 * wid + fr) * 512 + 8 * fq;
#pragma unroll 4
        for (int ks = 0; ks < 16; ++ks) {
            bf16x8 af[2];
#pragma unroll
            for (int tt = 0; tt < 2; ++tt) af[tt] = *(const LAS bf16x8*)(lds + (16 * tt + fr) * CV_A_ROWB + (32 * ks + 8 * fq) * 2);
#pragma unroll
            for (int nt = 0; nt < 4; ++nt) { const bf16x8 pf = *(const bf16x8*)(pw + (size_t)(16 * nt) * 512 + 32 * ks);
                acc[nt][0] = __builtin_amdgcn_mfma_f32_16x16x32_bf16(pf, af[0], acc[nt][0], 0, 0, 0);
                acc[nt][1] = __builtin_amdgcn_mfma_f32_16x16x32_bf16(pf, af[1], acc[nt][1], 0, 0, 0); }
        }
#pragma unroll
        for (int tt = 0; tt < 2; ++tt) {
            const int tok = b * SEQ + t0 + 16 * tt + fr;
#pragma unroll
            for (int nt = 0; nt < 4; ++nt) {
                const int n4 = 64 * wid + 16 * nt + 4 * fq;
                const f32x4 pb = *(const f32x4*)(pwb + n4);
                const u32x2 gw = *(const u32x2*)(Z + (size_t)tok * DIN + OFF_GC + n4);
                const float g0 = silu_f(bf_lo(gw.x)), g1 = silu_f(bf_hi(gw.x)), g2 = silu_f(bf_lo(gw.y)), g3 = silu_f(bf_hi(gw.y));
                u32x2 o; o.x = cvt_pk_bf16((acc[nt][tt][0] + pb[0]) * g0, (acc[nt][tt][1] + pb[1]) * g1); o.y = cvt_pk_bf16((acc[nt][tt][2] + pb[2]) * g2, (acc[nt][tt][3] + pb[3]) * g3);
                *(u32x2*)(YC + (size_t)tok * DMIX + 1536 + n4) = o;
            }
        }
    }
    __syncthreads();
}

#define XB_TMO      128
#define XB_XCNT(j)  (256  + 64 * (j))
#define XB_XSUB(j)  (1280 + 64 * (j))
#define XB_XGEN(j)  (2304 + 64 * (j))
#define XB_TOP      3328
#define XB_TOPGEN   3392
#define XCD_BAR_WORDS 3456
#define XB_SPIN_CAP (1u << 18)

__device__ __forceinline__ unsigned xb_ld(unsigned* p)              { return __hip_atomic_load(p, __ATOMIC_RELAXED, __HIP_MEMORY_SCOPE_AGENT); }
__device__ __forceinline__ unsigned xb_add(unsigned* p, unsigned v) { return __hip_atomic_fetch_add(p, v, __ATOMIC_RELAXED, __HIP_MEMORY_SCOPE_AGENT); }
__device__ __forceinline__ unsigned xb_xcc_id() { return (unsigned)__builtin_amdgcn_s_getreg((3 << 11) | 20) & 0xFu; }
#define XB_SPIN(cond, bar) do { unsigned _sp = 0; while (cond) { __builtin_amdgcn_s_sleep(1); \
    if ((++_sp & 255u) == 0u) { if (xb_ld(&(bar)[XB_TMO])) break; if (_sp > XB_SPIN_CAP) { atomicAdd(&(bar)[XB_TMO], 1u); break; } } } } while (0)

struct XcdBarrier {
    unsigned* bar; unsigned x;
    volatile LAS unsigned* st;
};

__device__ __forceinline__ XcdBarrier xcd_barrier_post(unsigned* bar, volatile LAS unsigned* st) {
    XcdBarrier b; b.bar = bar; b.x = xb_xcc_id(); b.st = st;
    if (threadIdx.x == 0) (void)xb_add(&bar[XB_XCNT(b.x)], 1u);
    return b;
}
__device__ __forceinline__ void xcd_barrier_complete(unsigned* bar, unsigned x, unsigned& nloc, unsigned& nx) {
    const unsigned G = gridDim.x * gridDim.y * gridDim.z;
    unsigned sum, cnt, mine, sp = 0u;
    for (;;) {
        sum = 0u; cnt = 0u; mine = 0u;
#pragma unroll
        for (unsigned j = 0; j < 16; ++j) { const unsigned c = xb_ld(&bar[XB_XCNT(j)]); sum += c; cnt += (c > 0u) ? 1u : 0u; mine = (j == x) ? c : mine; }
        if (sum == G) break;
        __builtin_amdgcn_s_sleep(1);
        if ((++sp & 255u) == 0u) { if (xb_ld(&bar[XB_TMO])) break; if (sp > XB_SPIN_CAP) { atomicAdd(&bar[XB_TMO], 1u); break; } }
    }
    nloc = mine > 0u ? mine : 1u; nx = cnt > 0u ? cnt : 1u;
}

__device__ __forceinline__ void xcd_barrier(const XcdBarrier& b) {
    asm volatile("s_waitcnt vmcnt(0)" ::: "memory");
    __syncthreads();
    if (threadIdx.x == 0) {
        unsigned* bar = b.bar;
        __builtin_amdgcn_s_waitcnt(0);
        unsigned nloc = b.st[0], nx = b.st[1];
        if (nloc == 0u) { xcd_barrier_complete(bar, b.x, nloc, nx); b.st[0] = nloc; b.st[1] = nx; }
        const unsigned old = xb_add(&bar[XB_XSUB(b.x)], 1u);
        const unsigned gen = old / nloc;
        if (old + 1u == (gen + 1u) * nloc) {
            __builtin_amdgcn_fence(__ATOMIC_RELEASE, "agent");
            asm volatile("s_waitcnt vmcnt(0)" ::: "memory");
            const unsigned og = xb_add(&bar[XB_TOP], 1u);
            const unsigned tg = og / nx;
            if (og + 1u == (tg + 1u) * nx) xb_add(&bar[XB_TOPGEN], 1u);
            else XB_SPIN(xb_ld(&bar[XB_TOPGEN]) == tg, bar);
            __builtin_amdgcn_fence(__ATOMIC_ACQUIRE, "agent");
            xb_add(&bar[XB_XGEN(b.x)], 1u);
            asm volatile("s_waitcnt vmcnt(0)" ::: "memory");
        } else {
            XB_SPIN(xb_ld(&bar[XB_XGEN(b.x)]) == gen, bar);
            __builtin_amdgcn_fence(__ATOMIC_ACQUIRE, "agent");
            asm volatile("s_waitcnt vmcnt(0)" ::: "memory");
        }
    }
    __syncthreads();
}

struct Params { const float* in[16]; float* out; unsigned char* ws; unsigned long long use_cg; };

__global__ void __launch_bounds__(512, 2) fwd_megakernel(Params p) {
    extern __shared__ __attribute__((aligned(16))) unsigned char lds_raw[];
    cg::grid_group grid = cg::this_grid();
    LAS unsigned char* lds = (LAS unsigned char*)lds_raw;
    const int G = gridDim.x, bx = blockIdx.x, NGW = G * 8;
    { volatile LAS unsigned* misc = (volatile LAS unsigned*)(lds + 131072); if (threadIdx.x < 64) misc[threadIdx.x] = 0u; }
    __syncthreads();
    XcdBarrier bar = xcd_barrier_post((unsigned*)(p.ws + WS_CTL), (volatile LAS unsigned*)(lds + 131072));
#define GRID_BAR() do { if (p.use_cg) grid.sync(); else xcd_barrier(bar); } while (0)
#define FRESH_IDS() int tid = threadIdx.x; asm volatile("" : "+v"(tid)); const int lane = tid & 63, wid = __builtin_amdgcn_readfirstlane(tid >> 6); const int gw = bx * 8 + wid; (void)gw; (void)lane
    unsigned char* ws = p.ws;
    const float* x = p.in[0]; const float* pre_g = p.in[1]; const float* w_in = p.in[2]; const float* rpb = p.in[3];
    const float* sgu_ln_g = p.in[4]; const float* sgu_ln_b = p.in[5]; const float* sgu_w = p.in[6]; const float* sgu_b = p.in[7];
    const float* conv_w = p.in[8]; const float* conv_b = p.in[9]; const float* conv_ln_g = p.in[10]; const float* conv_ln_b = p.in[11];
    const float* conv_pw_w = p.in[12]; const float* conv_pw_b = p.in[13]; const float* w_out = p.in[14]; const float* post_g = p.in[15];
    bf16_t* WinT = (bf16_t*)(ws + WS_WIN); bf16_t* WoutT = (bf16_t*)(ws + WS_WOUT); bf16_t* PwT = (bf16_t*)(ws + WS_PW); bf16_t* SgW = (bf16_t*)(ws + WS_SGW);
    float* SSQ = (float*)(ws + WS_SSQ); bf16_t* H = (bf16_t*)(ws + WS_H); bf16_t* Z = (bf16_t*)(ws + WS_Z); bf16_t* VT = (bf16_t*)(ws + WS_VT);
    bf16_t* YC = (bf16_t*)(ws + WS_YC); float* Y = (float*)(ws + WS_Y); float* X1 = (float*)(ws + WS_X1);

    {
        FRESH_IDS();
        LAS float* scr = (LAS float*)(lds + wid * 16384);
        constexpr int I_IN = (DM / 64) * (DIN / 32), I_OUT = (DMIX / 64) * (DM / 32), I_PW = (512 / 64) * (512 / 32);
        constexpr int NITEMS = 2 * (I_IN + I_OUT + I_PW);
        for (int it = gw; it < NITEMS; it += NGW) {
            int r = it;
            if (r < 2 * I_IN) { const int l = r / I_IN; p0_transpose_item(w_in + (size_t)l * DM * DIN, DM, DIN, WinT + (size_t)l * DIN * DM, scr, r % I_IN, lane); continue; } r -= 2 * I_IN;
            if (r < 2 * I_OUT) { const int l = r / I_OUT; p0_transpose_item(w_out + (size_t)l * DMIX * DM, DMIX, DM, WoutT + (size_t)l * DM * DMIX, scr, r % I_OUT, lane); continue; } r -= 2 * I_OUT;
            { const int l = r / I_PW; p0_transpose_item(conv_pw_w + (size_t)l * 512 * 512, 512, 512, PwT + (size_t)l * 512 * 512, scr, r % I_PW, lane); }
        }
        for (int i = gw * 64 + lane; i < 2 * 4 * 128 * 128 / 2; i += NGW * 64) { const f32x2 v = *(const f32x2*)(sgu_w + 2 * (size_t)i); ((unsigned*)SgW)[i] = cvt_pk_bf16(v[0], v[1]); }
        for (int m = gw; m < MTOK; m += NGW) row_update<false, false, true>(x + (size_t)m * DM, nullptr, nullptr, nullptr, pre_g, nullptr, H + (size_t)m * DM, lane);
    }
    GRID_BAR();

#pragma unroll 1
    for (int l = 0; l < DEPTH; ++l) {
        const float* xin = (l == 0) ? x : X1;
        float* xout = (l == DEPTH - 1) ? p.out : X1;
        {
            const bf16_t* W = WinT + (size_t)l * DIN * DM;
            { pg8::Gemm g{H, W, MTOK, DIN - 1024, DM}; pg8::StaticOrder S; S.init(MTOK, DIN - 1024, G, bx, 8, 4); pg8::EpiBf16 E{Z, DIN};
              pg8::gemm_phase<pg8::EpiBf16, pg8::StaticOrder>(lds, g, S, E); }
            { pg8::Gemm g{W + (size_t)OFF_V * DM, H, 1024, MTOK, DM}; pg8::StaticOrder S; S.init(1024, MTOK, G, bx, 1 << 30, 0); pg8::EpiBf16 E{VT, MTOK};
              pg8::gemm_phase<pg8::EpiBf16, pg8::StaticOrder>(lds, g, S, E); }
        }
        GRID_BAR();
        {
            { FRESH_IDS();
            for (int it = bx; it < 256; it += G)
                conv_item(lds, Z, PwT + (size_t)l * 512 * 512, conv_w + (size_t)l * 31 * 512, conv_b + l * 512, conv_ln_g + l * 512, conv_ln_b + l * 512, conv_pw_b + l * 512, YC, it, tid, wid, lane); }
            { FRESH_IDS();
            for (int it = bx; it < 256; it += G)
                sgu_item(lds, Z, SgW + (size_t)l * 4 * 128 * 128, sgu_ln_g + l * 512, sgu_ln_b + l * 512, sgu_b + l * 512, YC, it, wid, lane); }
            { FRESH_IDS();
            for (int wi = gw; wi < NB * 8 * 32 * 4; wi += NGW) {
                const int j = wi & 3, r = (wi >> 2) & 31, h = (wi >> 7) & 7, b = wi >> 10;
                attn_wave_item(Z, VT, rpb + (size_t)l * 8 * 15 * 31, YC, b, h, r, j, lane);
            } }
        }
        GRID_BAR();
        {
            pg8::Gemm g{YC, WoutT + (size_t)l * DM * DMIX, MTOK, DM, DMIX}; pg8::StaticOrder S; S.init(MTOK, DM, G, bx, 1 << 30, 0); pg8::EpiF32Ssq E{Y, DM, SSQ};
            pg8::gemm_phase<pg8::EpiF32Ssq, pg8::StaticOrder>(lds, g, S, E);
        }
        GRID_BAR();
        if (l == 0) {
            FRESH_IDS();
            for (int m = gw; m < MTOK; m += NGW)
                row_update<true, true, true>(xin + (size_t)m * DM, Y + (size_t)m * DM, SSQ + (size_t)m * 32, post_g + l * DM, pre_g + (l + 1) * DM, xout + (size_t)m * DM, H + (size_t)m * DM, lane);
            GRID_BAR();
        } else {
            FRESH_IDS();
            for (int m = gw; m < MTOK; m += NGW)
                row_update<true, true, false>(xin + (size_t)m * DM, Y + (size_t)m * DM, SSQ + (size_t)m * 32, post_g + l * DM, nullptr, xout + (size_t)m * DM, nullptr, lane);
        }
    }
}

extern "C" void kernel_launch(void* const* d_in, const int* in_sizes, int n_in, void* d_out, int out_size, void* d_ws, size_t ws_size, hipStream_t stream) {
    static int grid_blocks = 0;
    if (grid_blocks == 0) {
        if (n_in != 16 || ws_size < WS_END) { fprintf(stderr, "kernel_launch: unexpected n_in %d / ws_size %zu\n", n_in, ws_size); grid_blocks = -1; return; }
        int dev = 0, cus = 0, per_cu = 0;
        hipGetDevice(&dev);
        hipDeviceGetAttribute(&cus, hipDeviceAttributeMultiprocessorCount, dev);
        if (hipFuncSetAttribute((const void*)fwd_megakernel, hipFuncAttributeMaxDynamicSharedMemorySize, LDS_BYTES) != hipSuccess) fprintf(stderr, "kernel_launch: hipFuncSetAttribute failed\n");
        if (hipOccupancyMaxActiveBlocksPerMultiprocessor(&per_cu, (const void*)fwd_megakernel, 512, LDS_BYTES) != hipSuccess || per_cu < 1) { fprintf(stderr, "kernel_launch: occupancy query says %d\n", per_cu); per_cu = 1; }
        (void)hipGetLastError();
        grid_blocks = cus * 1;
    }
    if (grid_blocks < 0) return;
    if (hipMemsetAsync((char*)d_ws + WS_CTL, 0, CTL_BYTES, stream) != hipSuccess) { fprintf(stderr, "kernel_launch: memset failed\n"); return; }
    Params p{};
    for (int i = 0; i < 16; ++i) p.in[i] = (const float*)d_in[i];
    p.out = (float*)d_out; p.ws = (unsigned char*)d_ws;
    void* args[] = {&p};
    hipError_t e = hipLaunchCooperativeKernel((const void*)fwd_megakernel, dim3(grid_blocks), dim3(512), args, LDS_BYTES, stream);
    if (e != hipSuccess) fprintf(stderr, "cooperative launch failed: %s (grid %d)\n", hipGetErrorString(e), grid_blocks);
}
```

```cpp
#include <hip/hip_runtime.h>
#include <hip/hip_cooperative_groups.h>
#include <cstdio>
namespace cg = cooperative_groups;

#define LAS __attribute__((address_space(3)))
typedef unsigned short bf16_t;
typedef short bf16x8 __attribute__((ext_vector_type(8)));
typedef float f32x4 __attribute__((ext_vector_type(4)));
typedef float f32x2 __attribute__((ext_vector_type(2)));
typedef unsigned u32x4 __attribute__((ext_vector_type(4)));
typedef unsigned u32x2 __attribute__((ext_vector_type(2)));

constexpr int DM = 2048, NB = 4, SEQ = 2048, MTOK = NB * SEQ, DEPTH = 2;
constexpr int DIN = 7168, DMIX = 2048;
constexpr int OFF_Q = 0, OFF_K = 1024, OFF_V = 2048, OFF_GA = 3072, OFF_UB = 4096, OFF_VB = 4608, OFF_GB = 5120, OFF_AC = 5632, OFF_BC = 6144, OFF_GC = 6656;
constexpr float EPS = 1e-6f;

constexpr size_t MiB = 1u << 20;
constexpr size_t WS_WIN = 0;
constexpr size_t WS_WOUT = 56 * MiB;
constexpr size_t WS_PW = 72 * MiB;
constexpr size_t WS_SGW = 73 * MiB;
constexpr size_t WS_SSQ = 74 * MiB;
constexpr size_t WS_CTL = 75 * MiB;
constexpr size_t CTL_BYTES = 16384;
constexpr size_t WS_H = 76 * MiB;
constexpr size_t WS_Z = 108 * MiB;
constexpr size_t WS_VT = 220 * MiB;
constexpr size_t WS_YC = 236 * MiB;
constexpr size_t WS_Y = 268 * MiB;
constexpr size_t WS_X1 = 332 * MiB;
constexpr size_t WS_END = 396 * MiB;

constexpr int LDS_BYTES = 147456;

__device__ __forceinline__ unsigned cvt_pk_bf16(float lo, float hi) { unsigned r; asm volatile("v_cvt_pk_bf16_f32 %0, %1, %2" : "=v"(r) : "v"(lo), "v"(hi)); return r; }
__device__ __forceinline__ float bf_lo(unsigned w) { return __uint_as_float(w << 16); }
__device__ __forceinline__ float bf_hi(unsigned w) { return __uint_as_float(w & 0xffff0000u); }
__device__ __forceinline__ float wave_sum(float v) {
#pragma unroll
    for (int o = 1; o < 64; o <<= 1) v += __shfl_xor(v, o);
    return v;
}
__device__ __forceinline__ float gelu_f(float v) {
    const float av = fabsf(v), t = __builtin_amdgcn_rcpf(av * 0.2316418882f + 1.0f);
    float q = t * 0.5307027145f + (-0.7265760135f); q = q * t + 0.7107068705f; q = q * t + (-0.142248368f); q = q * t + 0.127414796f; q = q * t;
    const float e = __builtin_amdgcn_exp2f((v * v) * (-0.72134752044f));
    const float m = v * (q * e);
    return v < 0.f ? m : v - m;
}
__device__ __forceinline__ float sigmoid_f(float v) { return __builtin_amdgcn_rcpf(1.0f + __expf(-v)); }
__device__ __forceinline__ float silu_f(float v) { return v * __builtin_amdgcn_rcpf(1.0f + __expf(-v)); }
#define LDS_WAIT() asm volatile("s_waitcnt lgkmcnt(0)" ::: "memory")

namespace pg8 {
constexpr int BM = 256, BK = 64, HALF = 128, HTB = HALF * BK * 2, STAGE_BYTES = 8 * HTB, NXCD = 8, WGM = 8;
__device__ __forceinline__ int lds_byte(int r, int c) { const int st = (r >> 4) * 2 + (c >> 5), rr = r & 15, cc = c & 31, ob = rr * 64 + cc * 2; return st * 1024 + (ob ^ (((ob >> 9) & 1) << 5)); }
__device__ __forceinline__ void stage_rc(int b, int& R, int& C) { const int st = b / 1024, sb = b % 1024, swz = sb ^ (((sb >> 9) & 1) << 5); R = (st >> 1) * 16 + swz / 64; C = (st & 1) * 32 + (swz % 64) / 2; }
__device__ __forceinline__ int perm32(int rho) { const int n = rho >> 4, i = rho & 15; return 8 * (i >> 2) + 4 * n + (i & 3); }

struct Unit { int pm, pn; };
struct Gemm { const bf16_t* A; const bf16_t* Bt; int M, N, K; };

struct StaticOrder {
    int nM, nN, nwg, G, c, skip_from, skip;
    __device__ void init(int M, int N, int G_, int c_, int skip_from_, int skip_) { nM = M / BM; nN = N / BM; nwg = nM * nN; G = G_; c = c_; skip_from = skip_from_; skip = skip_; }
    __device__ bool next(int i, Unit& u) const {
        const long L = (long)i * G + c; if (L >= nwg) return false;
        int wgid = (int)L; { const int q = nwg / NXCD, r = nwg % NXCD, xcd = wgid % NXCD, off = wgid / NXCD; wgid = (xcd < r ? xcd * (q + 1) : r * (q + 1) + (xcd - r) * q) + off; }
        const int nig = WGM * nN, gid = wgid / nig, fm = gid * WGM, gsz = (nM - fm) < WGM ? (nM - fm) : WGM;
        u.pm = fm + ((wgid % nig) % gsz); u.pn = (wgid % nig) / gsz;
        if (u.pn >= skip_from) u.pn += skip;
        return true;
    }
    __device__ __forceinline__ void a_ready(const Unit&) const {}
    __device__ __forceinline__ void done(const Unit&) const {}
};

struct EpiBf16 {
    static constexpr bool PERM = true;
    bf16_t* O; int ldc;
    __device__ __forceinline__ void operator()(const f32x4 (&acc)[2][2][4][2], const Unit& u, int wr, int wc, int fr, int fq) const {
        const int row0 = u.pm * BM + wr * 64 + fr; const int col0 = u.pn * BM + wc * 32 + 8 * fq;
#pragma unroll
        for (int ai = 0; ai < 2; ++ai)
#pragma unroll
            for (int m = 0; m < 4; ++m) { bf16_t* rowp = O + (size_t)(row0 + ai * HALF + m * 16) * ldc + col0;
#pragma unroll
                for (int bj = 0; bj < 2; ++bj) { const f32x4 v0 = acc[ai][bj][m][0], v1 = acc[ai][bj][m][1];
                    u32x4 w; w.x = cvt_pk_bf16(v0[0], v0[1]); w.y = cvt_pk_bf16(v0[2], v0[3]); w.z = cvt_pk_bf16(v1[0], v1[1]); w.w = cvt_pk_bf16(v1[2], v1[3]);
                    *(u32x4*)(rowp + bj * HALF) = w; } }
    }
};
struct EpiF32Ssq {
    static constexpr bool PERM = false;
    float* C; int ldc; float* ssq;
    __device__ __forceinline__ void operator()(const f32x4 (&acc)[2][2][4][2], const Unit& u, int wr, int wc, int fr, int fq) const {
        const int row0 = u.pm * BM + wr * 64 + fr, col0 = u.pn * BM + wc * 32 + 4 * fq;
#pragma unroll
        for (int ai = 0; ai < 2; ++ai)
#pragma unroll
            for (int m = 0; m < 4; ++m) { const int row = row0 + ai * HALF + m * 16; float* rowp = C + (size_t)row * ldc + col0; float s = 0.f;
#pragma unroll
                for (int bj = 0; bj < 2; ++bj)
#pragma unroll
                    for (int n = 0; n < 2; ++n) { const f32x4 v = acc[ai][bj][m][n]; *(f32x4*)(rowp + bj * HALF + n * 16) = v; s += (v[0] * v[0] + v[1] * v[1]) + (v[2] * v[2] + v[3] * v[3]); }
                s += __shfl_xor(s, 16); s += __shfl_xor(s, 32);
                if (fq == 0) ssq[(size_t)row * 32 + u.pn * 4 + wc] = s; }
    }
};

template <class Epi, class Sched>
__device__ __forceinline__ void gemm_phase(LAS unsigned char* lds, const Gemm g, const Sched& S, const Epi& E) {
    int tid = threadIdx.x; asm volatile("" : "+v"(tid));
    const int wid = __builtin_amdgcn_readfirstlane(tid >> 6), lane = tid & 63, wr = wid >> 2, wc = wid & 3, fr = lane & 15, fq = lane >> 4;
    const int K = g.K, nt = K / BK;
    unsigned voffA[2], voffB[2];
#pragma unroll
    for (int i = 0; i < 2; ++i) { int R, C; stage_rc(tid * 16 + i * 8192, R, C); const int Rb = Epi::PERM ? ((R & ~31) + perm32(R & 31)) : R;
        voffA[i] = (unsigned)(R * K + C) * 2u; voffB[i] = (unsigned)(Rb * K + C) * 2u; }
    const size_t kstep = (size_t)(BK * 2);
    const size_t hstep = (size_t)HALF * K * 2;
    const size_t tstep = 2 * hstep;
    const unsigned ldsw = (unsigned)wid * 1024u;
    const int aoff = lds_byte(wr * 64 + fr, fq * 8), boff = lds_byte(wc * 32 + fr, fq * 8);
#define PG8_SA(b, h) (((b) * 2 + (h)) * HTB)
#define PG8_SB(b, h) ((4 + (b) * 2 + (h)) * HTB)
#define PG8_STAGE(bufoff, gbase, voff) do { _Pragma("unroll") for (int _i = 0; _i < 2; ++_i) \
        __builtin_amdgcn_global_load_lds((const unsigned*)((const char*)(gbase) + (voff)[_i]), (LAS unsigned*)(lds + (bufoff) + ldsw + _i * 8192), 16, 0, 0); } while (0)
#define PG8_LDA(dst, b, h) do { _Pragma("unroll") for (int m = 0; m < 4; ++m) _Pragma("unroll") for (int k = 0; k < 2; ++k) dst[m][k] = *(const LAS bf16x8*)(lds + PG8_SA(b, h) + aoff + m * 2048 + k * 1024); } while (0)
#define PG8_LDB(dst, b, h) do { _Pragma("unroll") for (int n = 0; n < 2; ++n) _Pragma("unroll") for (int k = 0; k < 2; ++k) dst[n][k] = *(const LAS bf16x8*)(lds + PG8_SB(b, h) + boff + n * 2048 + k * 1024); } while (0)
#define PG8_MMA(ai, bj, At, Bt) do { __builtin_amdgcn_s_setprio(1); _Pragma("unroll") for (int m = 0; m < 4; ++m) _Pragma("unroll") for (int n = 0; n < 2; ++n) _Pragma("unroll") for (int k = 0; k < 2; ++k) \
        acc[ai][bj][m][n] = __builtin_amdgcn_mfma_f32_16x16x32_bf16(Bt[n][k], At[m][k], acc[ai][bj][m][n], 0, 0, 0); __builtin_amdgcn_s_setprio(0); } while (0)
#define PG8_WAIT_V(n) asm volatile("s_waitcnt vmcnt(" #n ")" ::: "memory")
#define PG8_WAIT_L(n) asm volatile("s_waitcnt lgkmcnt(" #n ")" ::: "memory")
#define PG8_BAR __builtin_amdgcn_s_barrier()
#define PG8_SCHED __builtin_amdgcn_sched_barrier(0)
    Unit cur, nxt; int ui = 0;
    if (!S.next(0, cur)) return;
    f32x4 acc[2][2][4][2];
#pragma unroll
    for (int a = 0; a < 2; ++a)
#pragma unroll
        for (int b = 0; b < 2; ++b)
#pragma unroll
            for (int m = 0; m < 4; ++m)
#pragma unroll
                for (int n = 0; n < 2; ++n) acc[a][b][m][n] = (f32x4){0.f, 0.f, 0.f, 0.f};
    bf16x8 At[4][2], B0[2][2], B1[2][2];
    const char* cA = (const char*)g.A + (size_t)cur.pm * tstep; const char* cB = (const char*)g.Bt + (size_t)cur.pn * tstep;
    S.a_ready(cur);
    PG8_STAGE(PG8_SB(0, 0), cB, voffB); PG8_STAGE(PG8_SA(0, 0), cA, voffA); PG8_STAGE(PG8_SB(0, 1), cB + hstep, voffB); PG8_STAGE(PG8_SA(0, 1), cA + hstep, voffA);
    if (wr == 1) PG8_BAR;
    PG8_WAIT_V(4); PG8_BAR;
    PG8_STAGE(PG8_SB(1, 0), cB + kstep, voffB); PG8_STAGE(PG8_SA(1, 0), cA + kstep, voffA); PG8_STAGE(PG8_SB(1, 1), cB + hstep + kstep, voffB);
    PG8_WAIT_V(6); PG8_BAR;
    for (;;) {
        const bool has_next = S.next(ui + 1, nxt);
        const char* nA = has_next ? (const char*)g.A + (size_t)nxt.pm * tstep : cA; const char* nB = has_next ? (const char*)g.Bt + (size_t)nxt.pn * tstep : cB;
        for (int t = 0; t < nt; t += 2) {
            const bool last = (t == nt - 2);
            const char* a1 = cA + (size_t)(t + 1) * kstep;
            const char* a2 = last ? nA : cA + (size_t)(t + 2) * kstep; const char* b2 = last ? nB : cB + (size_t)(t + 2) * kstep;
            const char* a3 = a2 + kstep; const char* b3 = b2 + kstep;
            if (last && has_next) S.a_ready(nxt);
            PG8_LDB(B0, 0, 0); PG8_SCHED; PG8_LDA(At, 0, 0); PG8_STAGE(PG8_SA(1, 1), a1 + hstep, voffA);
            PG8_WAIT_L(8); PG8_BAR; PG8_WAIT_L(0); PG8_MMA(0, 0, At, B0); PG8_BAR; PG8_SCHED;
            PG8_LDB(B1, 0, 1); PG8_STAGE(PG8_SB(0, 0), b2, voffB);
            PG8_BAR; PG8_WAIT_L(0); PG8_MMA(0, 1, At, B1); PG8_BAR;
            PG8_LDA(At, 0, 1); PG8_STAGE(PG8_SA(0, 0), a2, voffA);
            PG8_BAR; PG8_WAIT_L(0); PG8_MMA(1, 0, At, B0); PG8_BAR; PG8_SCHED;
            PG8_STAGE(PG8_SB(0, 1), b2 + hstep, voffB);
            PG8_WAIT_V(6); PG8_BAR; PG8_MMA(1, 1, At, B1); PG8_BAR;
            PG8_LDB(B0, 1, 0); PG8_SCHED; PG8_LDA(At, 1, 0); PG8_STAGE(PG8_SA(0, 1), a2 + hstep, voffA);
            PG8_WAIT_L(8); PG8_BAR; PG8_WAIT_L(0); PG8_MMA(0, 0, At, B0); PG8_BAR; PG8_SCHED;
            PG8_LDB(B1, 1, 1); PG8_STAGE(PG8_SB(1, 0), b3, voffB);
            PG8_BAR; PG8_WAIT_L(0); PG8_MMA(0, 1, At, B1); PG8_BAR;
            PG8_LDA(At, 1, 1); PG8_STAGE(PG8_SA(1, 0), a3, voffA);
            PG8_BAR; PG8_WAIT_L(0); PG8_MMA(1, 0, At, B0); PG8_BAR; PG8_SCHED;
            PG8_STAGE(PG8_SB(1, 1), b3 + hstep, voffB);
            PG8_WAIT_V(6); PG8_BAR; PG8_MMA(1, 1, At, B1); PG8_BAR;
        }
        E(acc, cur, wr, wc, fr, fq); S.done(cur);
        if (!has_next) break;
#pragma unroll
        for (int a = 0; a < 2; ++a)
#pragma unroll
            for (int b = 0; b < 2; ++b)
#pragma unroll
                for (int m = 0; m < 4; ++m)
#pragma unroll
                    for (int n = 0; n < 2; ++n) acc[a][b][m][n] = (f32x4){0.f, 0.f, 0.f, 0.f};
        cur = nxt; cA = nA; cB = nB; ++ui;
    }
    PG8_WAIT_V(0);
    if (wr == 0) PG8_BAR;
    PG8_BAR;
#undef PG8_SA
#undef PG8_SB
#undef PG8_STAGE
#undef PG8_LDA
#undef PG8_LDB
#undef PG8_MMA
#undef PG8_WAIT_V
#undef PG8_WAIT_L
#undef PG8_BAR
#undef PG8_SCHED
}
}

__device__ __forceinline__ void p0_transpose_item(const float* W, int K, int N, bf16_t* WT, LAS float* scr, int item, int lane) {
    const int nblk = N / 32, kb = item / nblk, nb = item % nblk, k0 = 64 * kb, n0 = 32 * nb;
#pragma unroll 8
    for (int i = 0; i < 32; ++i) { const int kk = 2 * i + (lane >> 5); scr[kk * 33 + (lane & 31)] = W[(size_t)(k0 + kk) * N + n0 + (lane & 31)]; }
    LDS_WAIT(); asm volatile("" ::: "memory");
    const int c = lane & 7;
#pragma unroll
    for (int j = 0; j < 4; ++j) { const int n = (lane >> 3) + 8 * j; const LAS float* s = scr + (8 * c) * 33 + n;
        u32x4 o; o.x = cvt_pk_bf16(s[0 * 33], s[1 * 33]); o.y = cvt_pk_bf16(s[2 * 33], s[3 * 33]); o.z = cvt_pk_bf16(s[4 * 33], s[5 * 33]); o.w = cvt_pk_bf16(s[6 * 33], s[7 * 33]);
        *(u32x4*)(WT + (size_t)(n0 + n) * K + k0 + 8 * c) = o; }
    LDS_WAIT(); asm volatile("" ::: "memory");
}

template <bool HAS_Y, bool WRITE_X, bool WRITE_H>
__device__ __forceinline__ void row_update(const float* xrow, const float* yrow, const float* ssq_row, const float* gpost, const float* gpre, float* xout, bf16_t* hout, int lane) {
    f32x4 v[8];
    const f32x4* xr = (const f32x4*)xrow + lane;
#pragma unroll
    for (int j = 0; j < 8; ++j) v[j] = xr[64 * j];
    if (HAS_Y) {
        float s = ssq_row[lane & 31];
#pragma unroll
        for (int o = 1; o < 32; o <<= 1) s += __shfl_xor(s, o);
        const float rstd = 1.0f / sqrtf(s * (1.0f / DM) + EPS);
        const f32x4* yr = (const f32x4*)yrow + lane; const f32x4* gp = (const f32x4*)gpost + lane;
#pragma unroll
        for (int j = 0; j < 8; ++j) { const f32x4 y = yr[64 * j], g = gp[64 * j]; v[j] = v[j] + (y * rstd) * g; }
    }
    if (WRITE_X) { f32x4* xo = (f32x4*)xout + lane;
#pragma unroll
        for (int j = 0; j < 8; ++j) xo[64 * j] = v[j]; }
    if (WRITE_H) {
        float s2 = 0.f;
#pragma unroll
        for (int j = 0; j < 8; ++j) s2 += (v[j][0] * v[j][0] + v[j][1] * v[j][1]) + (v[j][2] * v[j][2] + v[j][3] * v[j][3]);
        const float rstd2 = 1.0f / sqrtf(wave_sum(s2) * (1.0f / DM) + EPS);
        const f32x4* gq = (const f32x4*)gpre + lane; u32x2* ho = (u32x2*)hout + lane;
#pragma unroll
        for (int j = 0; j < 8; ++j) { const f32x4 g = gq[64 * j]; u32x2 w; w.x = cvt_pk_bf16(v[j][0] * rstd2 * g[0], v[j][1] * rstd2 * g[1]); w.y = cvt_pk_bf16(v[j][2] * rstd2 * g[2], v[j][3] * rstd2 * g[3]); ho[64 * j] = w; }
    }
}

#define SCHED_BAR() __builtin_amdgcn_sched_barrier(0)
__device__ __forceinline__ void attn_wave_item(const bf16_t* Z, const bf16_t* VT, const LAS float* rpbl, bf16_t* YC, int b, int h, int r, int j, int lane) {
    const int fr = lane & 15, fq = lane >> 4;
    const int rs = min(max(r - 4, 0), 24);
    const int kc0 = (j == 0) ? 0 : (j == 1) ? 8 : (j == 2) ? 24 : 32;
    const int w = j * 16 + fr;
    const int tokq = b * SEQ + r * 64 + w;
    const int cs = min(max(w - 8, 0), 48);
    bf16x8 qf[4];
    { const bf16_t* qp = Z + (size_t)tokq * DIN + OFF_Q + h * 128 + 8 * fq;
#pragma unroll
      for (int s = 0; s < 4; ++s) qf[s] = *(const bf16x8*)(qp + 32 * s); }
    const int kcl = 8 * (fr >> 2) + (fr & 3);
    const bf16_t* kbase = Z + (size_t)(b * SEQ + rs * 64 + kc0 + kcl) * DIN + OFF_K + h * 128 + 8 * fq;
    bf16x8 kb[2][16];
#define ATT_LOADK(buf, bt) do { _Pragma("unroll") for (int ii = 0; ii < 2; ++ii) _Pragma("unroll") for (int hf = 0; hf < 2; ++hf) _Pragma("unroll") for (int s = 0; s < 4; ++s) \
        kb[buf][(ii * 2 + hf) * 4 + s] = *(const bf16x8*)(kbase + (size_t)((2 * (bt) + ii) * 64 + 4 * hf) * DIN + 32 * s); } while (0)
    f32x4 sacc[8][2];
    ATT_LOADK(0, 0);
#pragma unroll
    for (int bt = 0; bt < 4; ++bt) {
        if (bt < 3) ATT_LOADK((bt + 1) & 1, bt + 1);
        SCHED_BAR();
#pragma unroll
        for (int ii = 0; ii < 2; ++ii)
#pragma unroll
            for (int hf = 0; hf < 2; ++hf) {
                f32x4 a = (f32x4){0.f, 0.f, 0.f, 0.f};
#pragma unroll
                for (int s = 0; s < 4; ++s) a = __builtin_amdgcn_mfma_f32_16x16x32_bf16(kb[bt & 1][(ii * 2 + hf) * 4 + s], qf[s], a, 0, 0, 0);
                sacc[2 * bt + ii][hf] = a;
            }
        SCHED_BAR();
    }
#undef ATT_LOADK
    const bf16_t* vbase = VT + (size_t)(h * 128 + fr) * MTOK + b * SEQ + rs * 64 + kc0 + 8 * fq;
    bf16x8 vb[2][16];
#define ATT_LOADV(buf, bt) do { _Pragma("unroll") for (int ii = 0; ii < 2; ++ii) _Pragma("unroll") for (int dt = 0; dt < 8; ++dt) \
        vb[buf][ii * 8 + dt] = *(const bf16x8*)(vbase + (size_t)(16 * dt) * MTOK + (2 * (bt) + ii) * 64); } while (0)
    ATT_LOADV(0, 0);
    SCHED_BAR();
    const float scale = 0.08838834764831845f;
    const LAS float* rp = rpbl + h * (15 * 31);
    float mx = -1e30f;
#pragma unroll
    for (int i = 0; i < 8; ++i) {
        const int dr = rs + i - r + 7;
#pragma unroll
        for (int hf = 0; hf < 2; ++hf)
#pragma unroll
            for (int rg = 0; rg < 4; ++rg) {
                const int kc = kc0 + 8 * fq + 4 * hf + rg;
                const bool valid = (kc >= cs) && (kc < cs + 16);
                const int dc = min(max(kc - w + 15, 0), 30);
                const float sv = sacc[i][hf][rg] * scale + rp[dr * 31 + dc];
                sacc[i][hf][rg] = valid ? sv : -1e30f;
                mx = fmaxf(mx, sacc[i][hf][rg]);
            }
    }
    mx = fmaxf(mx, __shfl_xor(mx, 16)); mx = fmaxf(mx, __shfl_xor(mx, 32));
    float sum = 0.f;
    bf16x8 pf[8];
#pragma unroll
    for (int i = 0; i < 8; ++i) {
        float pv[8];
#pragma unroll
        for (int hf = 0; hf < 2; ++hf)
#pragma unroll
            for (int rg = 0; rg < 4; ++rg) { const float sv = sacc[i][hf][rg]; const float pe = (sv > -1e29f) ? __expf(sv - mx) : 0.f; pv[hf * 4 + rg] = pe; sum += pe; }
        u32x4 pk; pk.x = cvt_pk_bf16(pv[0], pv[1]); pk.y = cvt_pk_bf16(pv[2], pv[3]); pk.z = cvt_pk_bf16(pv[4], pv[5]); pk.w = cvt_pk_bf16(pv[6], pv[7]);
        pf[i] = __builtin_bit_cast(bf16x8, pk);
    }
    sum += __shfl_xor(sum, 16); sum += __shfl_xor(sum, 32);
    const float inv = __builtin_amdgcn_rcpf(sum);
    f32x4 oacc[8];
#pragma unroll
    for (int dt = 0; dt < 8; ++dt) oacc[dt] = (f32x4){0.f, 0.f, 0.f, 0.f};
    const bf16_t* gp = Z + (size_t)tokq * DIN + OFF_GA + h * 128 + 4 * fq;
    u32x2 gwv[8];
#pragma unroll
    for (int bt = 0; bt < 4; ++bt) {
        if (bt < 3) ATT_LOADV((bt + 1) & 1, bt + 1);
        else {
#pragma unroll
            for (int dt = 0; dt < 8; ++dt) gwv[dt] = *(const u32x2*)(gp + 16 * dt);
        }
        SCHED_BAR();
#pragma unroll
        for (int ii = 0; ii < 2; ++ii)
#pragma unroll
            for (int dt = 0; dt < 8; ++dt) oacc[dt] = __builtin_amdgcn_mfma_f32_16x16x32_bf16(vb[bt & 1][ii * 8 + dt], pf[2 * bt + ii], oacc[dt], 0, 0, 0);
        SCHED_BAR();
    }
#undef ATT_LOADV
    bf16_t* op = YC + (size_t)tokq * DMIX + h * 128 + 4 * fq;
#pragma unroll
    for (int dt = 0; dt < 8; ++dt) {
        const u32x2 gw = gwv[dt];
        const float g0 = silu_f(bf_lo(gw.x)), g1 = silu_f(bf_hi(gw.x)), g2 = silu_f(bf_lo(gw.y)), g3 = silu_f(bf_hi(gw.y));
        u32x2 o; o.x = cvt_pk_bf16(oacc[dt][0] * inv * g0, oacc[dt][1] * inv * g1); o.y = cvt_pk_bf16(oacc[dt][2] * inv * g2, oacc[dt][3] * inv * g3);
        *(u32x2*)(op + 16 * dt) = o;
    }
}

constexpr int SGU_ROWB = 272;
__device__ __forceinline__ void sgu_item(LAS unsigned char* lds, const bf16_t* Z, const bf16_t* SGW, const float* ln_g, const float* ln_b, const float* b_s, bf16_t* YC, int item, int wid, int lane) {
    const int g = item & 3, bn = item >> 2;
    const int tk0 = bn * 128;
    const int fr = lane & 15, fq = lane >> 4;
    float lg[8], lb[8];
    { const f32x4* gp4 = (const f32x4*)(ln_g + 8 * lane); const f32x4* bp4 = (const f32x4*)(ln_b + 8 * lane); const f32x4 a0 = gp4[0], a1 = gp4[1], c0 = bp4[0], c1 = bp4[1];
      lg[0] = a0[0]; lg[1] = a0[1]; lg[2] = a0[2]; lg[3] = a0[3]; lg[4] = a1[0]; lg[5] = a1[1]; lg[6] = a1[2]; lg[7] = a1[3];
      lb[0] = c0[0]; lb[1] = c0[1]; lb[2] = c0[2]; lb[3] = c0[3]; lb[4] = c1[0]; lb[5] = c1[1]; lb[6] = c1[2]; lb[7] = c1[3]; }
#pragma unroll 1
    for (int hb = 0; hb < 2; ++hb) {
        u32x4 raw[8];
#pragma unroll
        for (int q = 0; q < 8; ++q) raw[q] = *(const u32x4*)(Z + (size_t)(tk0 + 16 * wid + 8 * hb + q) * DIN + OFF_VB + 8 * lane);
        SCHED_BAR();
        float x[8][8], sm[8];
#pragma unroll
        for (int q = 0; q < 8; ++q) {
            x[q][0] = bf_lo(raw[q].x); x[q][1] = bf_hi(raw[q].x); x[q][2] = bf_lo(raw[q].y); x[q][3] = bf_hi(raw[q].y); x[q][4] = bf_lo(raw[q].z); x[q][5] = bf_hi(raw[q].z); x[q][6] = bf_lo(raw[q].w); x[q][7] = bf_hi(raw[q].w);
            float a = 0.f;
#pragma unroll
            for (int e = 0; e < 8; ++e) { x[q][e] = gelu_f(x[q][e]); a += x[q][e]; }
            sm[q] = a;
        }
#pragma unroll
        for (int o = 1; o < 64; o <<= 1)
#pragma unroll
            for (int q = 0; q < 8; ++q) sm[q] += __shfl_xor(sm[q], o);
        float sq[8];
#pragma unroll
        for (int q = 0; q < 8; ++q) { const float mean = sm[q] * (1.0f / 512.0f); float a = 0.f;
#pragma unroll
            for (int e = 0; e < 8; ++e) { x[q][e] -= mean; a += x[q][e] * x[q][e]; }
            sq[q] = a; }
#pragma unroll
        for (int o = 1; o < 64; o <<= 1)
#pragma unroll
            for (int q = 0; q < 8; ++q) sq[q] += __shfl_xor(sq[q], o);
        if ((lane >> 4) == g) {
            const int cl = 8 * (lane & 15);
#pragma unroll
            for (int q = 0; q < 8; ++q) { const float rstd = 1.0f / sqrtf(sq[q] * (1.0f / 512.0f) + EPS); const int s = 16 * wid + 8 * hb + q;
#pragma unroll
                for (int e = 0; e < 8; ++e) { const float y = x[q][e] * rstd * lg[e] + lb[e]; *(LAS bf16_t*)(lds + (cl + e) * SGU_ROWB + s * 2) = (bf16_t)(cvt_pk_bf16(y, 0.f) & 0xffffu); } }
        }
    }
    const int t = 16 * wid + fr, tok = tk0 + t;
    const bf16_t* zr = Z + (size_t)tok * DIN + g * 128 + 4 * fq;
    u32x2 uwv[8], gwv[8];
#pragma unroll
    for (int ct = 0; ct < 8; ++ct) { uwv[ct] = *(const u32x2*)(zr + OFF_UB + 16 * ct); gwv[ct] = *(const u32x2*)(zr + OFF_GB + 16 * ct); }
    const float bs = b_s[g * 128 + t];
    bf16x8 wf[4];
    { const bf16_t* wp = SGW + (size_t)(g * 128 + 16 * wid + fr) * 128 + 8 * fq;
#pragma unroll
      for (int ks = 0; ks < 4; ++ks) wf[ks] = *(const bf16x8*)(wp + 32 * ks); }
    __syncthreads();
    f32x4 acc[8];
#pragma unroll
    for (int ct = 0; ct < 8; ++ct) {
        f32x4 a = (f32x4){0.f, 0.f, 0.f, 0.f};
#pragma unroll
        for (int ks = 0; ks < 4; ++ks) { const bf16x8 vf = *(const LAS bf16x8*)(lds + (16 * ct + fr) * SGU_ROWB + (32 * ks + 8 * fq) * 2); a = __builtin_amdgcn_mfma_f32_16x16x32_bf16(vf, wf[ks], a, 0, 0, 0); }
        acc[ct] = a;
    }
    bf16_t* op = YC + (size_t)tok * DMIX + 1024 + g * 128 + 4 * fq;
#pragma unroll
    for (int ct = 0; ct < 8; ++ct) {
        const u32x2 uw = uwv[ct], gw = gwv[ct];
        const float u0 = gelu_f(bf_lo(uw.x)), u1 = gelu_f(bf_hi(uw.x)), u2 = gelu_f(bf_lo(uw.y)), u3 = gelu_f(bf_hi(uw.y));
        const float g0 = silu_f(bf_lo(gw.x)), g1 = silu_f(bf_hi(gw.x)), g2 = silu_f(bf_lo(gw.y)), g3 = silu_f(bf_hi(gw.y));
        u32x2 o; o.x = cvt_pk_bf16(u0 * (acc[ct][0] + bs) * g0, u1 * (acc[ct][1] + bs) * g1); o.y = cvt_pk_bf16(u2 * (acc[ct][2] + bs) * g2, u3 * (acc[ct][3] + bs) * g3);
        *(u32x2*)(op + 16 * ct) = o;
    }
    __syncthreads();
}

constexpr int CV_G_OFF = 0, CV_G_ROWS = 62, CV_C_OFF = 63488, CV_A_ROWB = 1040;
__device__ __forceinline__ unsigned glu_pk(unsigned a, unsigned b) { return cvt_pk_bf16(bf_lo(a) * sigmoid_f(bf_lo(b)), bf_hi(a) * sigmoid_f(bf_hi(b))); }
__device__ __forceinline__ void conv_item(LAS unsigned char* lds, const bf16_t* Z, const bf16_t* PWT, const float* cw, const float* cb, const float* ln_g, const float* ln_b, const float* pwb, bf16_t* YC, int item, int tid, int wid, int lane) {
    const int b = item >> 6, t0 = (item & 63) * 32;
#define REOPAQUE() do { asm volatile("" : "+v"(tid)); lane = tid & 63; fr = lane & 15; fq = lane >> 4; } while (0)
    int fr, fq;
    REOPAQUE();
#pragma unroll 1
    for (int ps = 0; ps < 2; ++ps) {
        u32x4 av[4], bv[4]; bool ok[4];
#pragma unroll
        for (int q = 0; q < 4; ++q) {
            const int wk = tid + 512 * (4 * ps + q), tt = wk >> 6, c8 = (wk & 63) * 8, pp = t0 - 15 + tt;
            ok[q] = (tt < CV_G_ROWS) && (pp >= 0) && (pp < SEQ);
            av[q] = (u32x4){0u, 0u, 0u, 0u}; bv[q] = (u32x4){0u, 0u, 0u, 0u};
            if (ok[q]) { const bf16_t* zr = Z + (size_t)(b * SEQ + pp) * DIN + c8; av[q] = *(const u32x4*)(zr + OFF_AC); bv[q] = *(const u32x4*)(zr + OFF_BC); }
        }
        SCHED_BAR();
#pragma unroll
        for (int q = 0; q < 4; ++q) {
            const int wk = tid + 512 * (4 * ps + q), tt = wk >> 6, c8 = (wk & 63) * 8;
            u32x4 o; o.x = glu_pk(av[q].x, bv[q].x); o.y = glu_pk(av[q].y, bv[q].y); o.z = glu_pk(av[q].z, bv[q].z); o.w = glu_pk(av[q].w, bv[q].w);
            if (tt < CV_G_ROWS) *(LAS u32x4*)(lds + CV_G_OFF + tt * 1024 + c8 * 2) = o;
        }
    }
    __syncthreads();
    REOPAQUE();
    {
        const int cp = tid & 255, th = tid >> 8;
        float w0[31], w1[31];
#pragma unroll
        for (int jj = 0; jj < 31; ++jj) { const f32x2 wv = *(const f32x2*)(cw + jj * 512 + 2 * cp); w0[jj] = wv[0]; w1[jj] = wv[1]; }
        const f32x2 bias = *(const f32x2*)(cb + 2 * cp);
        float a0[16], a1[16];
#pragma unroll
        for (int o = 0; o < 16; ++o) { a0[o] = bias[0]; a1[o] = bias[1]; }
#pragma unroll
        for (int tl = 0; tl < 46; ++tl) {
            const unsigned gv = *(const LAS unsigned*)(lds + CV_G_OFF + (16 * th + tl) * 1024 + cp * 4);
            const float h0 = bf_lo(gv), h1 = bf_hi(gv);
#pragma unroll
            for (int o = 0; o < 16; ++o) { const int jj = tl - o; if (jj >= 0 && jj <= 30) { a0[o] += h0 * w0[jj]; a1[o] += h1 * w1[jj]; } }
        }
#pragma unroll
        for (int o = 0; o < 16; ++o) *(LAS f32x2*)(lds + CV_C_OFF + (16 * th + o) * 2048 + cp * 8) = (f32x2){a0[o], a1[o]};
    }
    __syncthreads();
    REOPAQUE();
    const bf16_t* pw = PWT + (size_t)(64 * wid + fr) * 512 + 8 * fq;
    bf16x8 pfb[2][4];
#pragma unroll
    for (int nt = 0; nt < 4; ++nt) pfb[0][nt] = *(const bf16x8*)(pw + (size_t)(16 * nt) * 512);
    {
        const f32x4 g0 = *(const f32x4*)(ln_g + 8 * lane), g1 = *(const f32x4*)(ln_g + 8 * lane + 4), b0 = *(const f32x4*)(ln_b + 8 * lane), b1 = *(const f32x4*)(ln_b + 8 * lane + 4);
        f32x4 x0[4], x1[4]; float sm[4], sq[4];
#pragma unroll
        for (int q = 0; q < 4; ++q) { const int t = 4 * wid + q;
            x0[q] = *(const LAS f32x4*)(lds + CV_C_OFF + t * 2048 + lane * 32); x1[q] = *(const LAS f32x4*)(lds + CV_C_OFF + t * 2048 + lane * 32 + 16);
            sm[q] = (x0[q][0] + x0[q][1]) + (x0[q][2] + x0[q][3]) + (x1[q][0] + x1[q][1]) + (x1[q][2] + x1[q][3]); }
#pragma unroll
        for (int o = 1; o < 64; o <<= 1)
#pragma unroll
            for (int q = 0; q < 4; ++q) sm[q] += __shfl_xor(sm[q], o);
#pragma unroll
        for (int q = 0; q < 4; ++q) { const float mean = sm[q] * (1.0f / 512.0f); x0[q] = x0[q] - mean; x1[q] = x1[q] - mean;
            sq[q] = (x0[q][0] * x0[q][0] + x0[q][1] * x0[q][1]) + (x0[q][2] * x0[q][2] + x0[q][3] * x0[q][3]) + (x1[q][0] * x1[q][0] + x1[q][1] * x1[q][1]) + (x1[q][2] * x1[q][2] + x1[q][3] * x1[q][3]); }
#pragma unroll
        for (int o = 1; o < 64; o <<= 1)
#pragma unroll
            for (int q = 0; q < 4; ++q) sq[q] += __shfl_xor(sq[q], o);
#pragma unroll
        for (int q = 0; q < 4; ++q) { const int t = 4 * wid + q;
            const float rstd = 1.0f / sqrtf(sq[q] * (1.0f / 512.0f) + EPS);
            const f32x4 y0 = x0[q] * rstd * g0 + b0, y1 = x1[q] * rstd * g1 + b1;
            u32x4 o; o.x = cvt_pk_bf16(silu_f(y0[0]), silu_f(y0[1])); o.y = cvt_pk_bf16(silu_f(y0[2]), silu_f(y0[3])); o.z = cvt_pk_bf16(silu_f(y1[0]), silu_f(y1[1])); o.w = cvt_pk_bf16(silu_f(y1[2]), silu_f(y1[3]));
            *(LAS u32x4*)(lds + t * CV_A_ROWB + lane * 16) = o; }
    }
    __syncthreads();
    {
        f32x4 acc[4][2];
#pragma unroll
        for (int nt = 0; nt < 4; ++nt) { acc[nt][0] = (f32x4){0.f, 0.f, 0.f, 0.f}; acc[nt][1] = (f32x4){0.f, 0.f, 0.f, 0.f}; }
#pragma unroll
        for (int ks = 0; ks < 16; ++ks) {
            if (ks < 15) {
#pragma unroll
                for (int nt = 0; nt < 4; ++nt) pfb[(ks + 1) & 1][nt] = *(const bf16x8*)(pw + (size_t)(16 * nt) * 512 + 32 * (ks + 1));
            }
            SCHED_BAR();
            bf16x8 af[2];
#pragma unroll
            for (int tt = 0; tt < 2; ++tt) af[tt] = *(const LAS bf16x8*)(lds + (16 * tt + fr) * CV_A_ROWB + (32 * ks + 8 * fq) * 2);
#pragma unroll
            for (int nt = 0; nt < 4; ++nt) {
                acc[nt][0] = __builtin_amdgcn_mfma_f32_16x16x32_bf16(pfb[ks & 1][nt], af[0], acc[nt][0], 0, 0, 0);
                acc[nt][1] = __builtin_amdgcn_mfma_f32_16x16x32_bf16(pfb[ks & 1][nt], af[1], acc[nt][1], 0, 0, 0); }
            SCHED_BAR();
        }
        REOPAQUE();
        u32x2 gwv[2][4]; f32x4 pbv[4];
#pragma unroll
        for (int nt = 0; nt < 4; ++nt) { const int n4 = 64 * wid + 16 * nt + 4 * fq; pbv[nt] = *(const f32x4*)(pwb + n4);
#pragma unroll
            for (int tt = 0; tt < 2; ++tt) gwv[tt][nt] = *(const u32x2*)(Z + (size_t)(b * SEQ + t0 + 16 * tt + fr) * DIN + OFF_GC + n4); }
        SCHED_BAR();
#pragma unroll
        for (int tt = 0; tt < 2; ++tt) {
            const int tok = b * SEQ + t0 + 16 * tt + fr;
#pragma unroll
            for (int nt = 0; nt < 4; ++nt) {
                const int n4 = 64 * wid + 16 * nt + 4 * fq;
                const f32x4 pb = pbv[nt]; const u32x2 gw = gwv[tt][nt];
                const float g0 = silu_f(bf_lo(gw.x)), g1 = silu_f(bf_hi(gw.x)), g2 = silu_f(bf_lo(gw.y)), g3 = silu_f(bf_hi(gw.y));
                u32x2 o; o.x = cvt_pk_bf16((acc[nt][tt][0] + pb[0]) * g0, (acc[nt][tt][1] + pb[1]) * g1); o.y = cvt_pk_bf16((acc[nt][tt][2] + pb[2]) * g2, (acc[nt][tt][3] + pb[3]) * g3);
                *(u32x2*)(YC + (size_t)tok * DMIX + 1536 + n4) = o;
            }
        }
    }
    __syncthreads();
#undef REOPAQUE
}

#define XB_TMO      128
#define XB_XCNT(j)  (256  + 64 * (j))
#define XB_XSUB(j)  (1280 + 64 * (j))
#define XB_XGEN(j)  (2304 + 64 * (j))
#define XB_TOP      3328
#define XB_TOPGEN   3392
#define XCD_BAR_WORDS 3456
#define XB_SPIN_CAP (1u << 18)

__device__ __forceinline__ unsigned xb_ld(unsigned* p)              { return __hip_atomic_load(p, __ATOMIC_RELAXED, __HIP_MEMORY_SCOPE_AGENT); }
__device__ __forceinline__ unsigned xb_add(unsigned* p, unsigned v) { return __hip_atomic_fetch_add(p, v, __ATOMIC_RELAXED, __HIP_MEMORY_SCOPE_AGENT); }
__device__ __forceinline__ unsigned xb_xcc_id() { return (unsigned)__builtin_amdgcn_s_getreg((3 << 11) | 20) & 0xFu; }
#define XB_SPIN(cond, bar) do { unsigned _sp = 0; while (cond) { __builtin_amdgcn_s_sleep(1); \
    if ((++_sp & 255u) == 0u) { if (xb_ld(&(bar)[XB_TMO])) break; if (_sp > XB_SPIN_CAP) { atomicAdd(&(bar)[XB_TMO], 1u); break; } } } } while (0)

struct XcdBarrier {
    unsigned* bar; unsigned x;
    volatile LAS unsigned* st;
};

__device__ __forceinline__ XcdBarrier xcd_barrier_post(unsigned* bar, volatile LAS unsigned* st) {
    XcdBarrier b; b.bar = bar; b.x = xb_xcc_id(); b.st = st;
    if (threadIdx.x == 0) (void)xb_add(&bar[XB_XCNT(b.x)], 1u);
    return b;
}
__device__ __forceinline__ void xcd_barrier_complete(unsigned* bar, unsigned x, unsigned& nloc, unsigned& nx) {
    const unsigned G = gridDim.x * gridDim.y * gridDim.z;
    unsigned sum, cnt, mine, sp = 0u;
    for (;;) {
        sum = 0u; cnt = 0u; mine = 0u;
#pragma unroll
        for (unsigned j = 0; j < 16; ++j) { const unsigned c = xb_ld(&bar[XB_XCNT(j)]); sum += c; cnt += (c > 0u) ? 1u : 0u; mine = (j == x) ? c : mine; }
        if (sum == G) break;
        __builtin_amdgcn_s_sleep(1);
        if ((++sp & 255u) == 0u) { if (xb_ld(&bar[XB_TMO])) break; if (sp > XB_SPIN_CAP) { atomicAdd(&bar[XB_TMO], 1u); break; } }
    }
    nloc = mine > 0u ? mine : 1u; nx = cnt > 0u ? cnt : 1u;
}

__device__ __forceinline__ void xcd_barrier(const XcdBarrier& b) {
    asm volatile("s_waitcnt vmcnt(0)" ::: "memory");
    __syncthreads();
    if (threadIdx.x == 0) {
        unsigned* bar = b.bar;
        __builtin_amdgcn_s_waitcnt(0);
        unsigned nloc = b.st[0], nx = b.st[1];
        if (nloc == 0u) { xcd_barrier_complete(bar, b.x, nloc, nx); b.st[0] = nloc; b.st[1] = nx; }
        const unsigned old = xb_add(&bar[XB_XSUB(b.x)], 1u);
        const unsigned gen = old / nloc;
        if (old + 1u == (gen + 1u) * nloc) {
            __builtin_amdgcn_fence(__ATOMIC_RELEASE, "agent");
            asm volatile("s_waitcnt vmcnt(0)" ::: "memory");
            const unsigned og = xb_add(&bar[XB_TOP], 1u);
            const unsigned tg = og / nx;
            if (og + 1u == (tg + 1u) * nx) xb_add(&bar[XB_TOPGEN], 1u);
            else XB_SPIN(xb_ld(&bar[XB_TOPGEN]) == tg, bar);
            __builtin_amdgcn_fence(__ATOMIC_ACQUIRE, "agent");
            xb_add(&bar[XB_XGEN(b.x)], 1u);
            asm volatile("s_waitcnt vmcnt(0)" ::: "memory");
        } else {
            XB_SPIN(xb_ld(&bar[XB_XGEN(b.x)]) == gen, bar);
            __builtin_amdgcn_fence(__ATOMIC_ACQUIRE, "agent");
            asm volatile("s_waitcnt vmcnt(0)" ::: "memory");
        }
    }
    __syncthreads();
}

struct Params { const float* in[16]; float* out; unsigned char* ws; unsigned long long use_cg; };

__global__ void __launch_bounds__(512, 2) fwd_megakernel(Params p) {
    extern __shared__ __attribute__((aligned(16))) unsigned char lds_raw[];
    cg::grid_group grid = cg::this_grid();
    LAS unsigned char* lds = (LAS unsigned char*)lds_raw;
    const int G = gridDim.x, bx = blockIdx.x, NGW = G * 8;
    { volatile LAS unsigned* misc = (volatile LAS unsigned*)(lds + 131072); if (threadIdx.x < 64) misc[threadIdx.x] = 0u; }
    __syncthreads();
    XcdBarrier bar = xcd_barrier_post((unsigned*)(p.ws + WS_CTL), (volatile LAS unsigned*)(lds + 131072));
#define GRID_BAR() do { if (p.use_cg) grid.sync(); else xcd_barrier(bar); } while (0)
#define FRESH_IDS() int tid = threadIdx.x; asm volatile("" : "+v"(tid)); const int lane = tid & 63, wid = __builtin_amdgcn_readfirstlane(tid >> 6); const int gw = bx * 8 + wid; (void)gw; (void)lane
    unsigned char* ws = p.ws;
    const float* x = p.in[0]; const float* pre_g = p.in[1]; const float* w_in = p.in[2]; const float* rpb = p.in[3];
    const float* sgu_ln_g = p.in[4]; const float* sgu_ln_b = p.in[5]; const float* sgu_w = p.in[6]; const float* sgu_b = p.in[7];
    const float* conv_w = p.in[8]; const float* conv_b = p.in[9]; const float* conv_ln_g = p.in[10]; const float* conv_ln_b = p.in[11];
    const float* conv_pw_w = p.in[12]; const float* conv_pw_b = p.in[13]; const float* w_out = p.in[14]; const float* post_g = p.in[15];
    bf16_t* WinT = (bf16_t*)(ws + WS_WIN); bf16_t* WoutT = (bf16_t*)(ws + WS_WOUT); bf16_t* PwT = (bf16_t*)(ws + WS_PW); bf16_t* SgW = (bf16_t*)(ws + WS_SGW);
    float* SSQ = (float*)(ws + WS_SSQ); bf16_t* H = (bf16_t*)(ws + WS_H); bf16_t* Z = (bf16_t*)(ws + WS_Z); bf16_t* VT = (bf16_t*)(ws + WS_VT);
    bf16_t* YC = (bf16_t*)(ws + WS_YC); float* Y = (float*)(ws + WS_Y); float* X1 = (float*)(ws + WS_X1);

    {
        FRESH_IDS();
        LAS float* scr = (LAS float*)(lds + wid * 16384);
        constexpr int I_IN = (DM / 64) * (DIN / 32), I_OUT = (DMIX / 64) * (DM / 32), I_PW = (512 / 64) * (512 / 32);
        constexpr int NITEMS = 2 * (I_IN + I_OUT + I_PW);
        for (int it = gw; it < NITEMS; it += NGW) {
            int r = it;
            if (r < 2 * I_IN) { const int l = r / I_IN; p0_transpose_item(w_in + (size_t)l * DM * DIN, DM, DIN, WinT + (size_t)l * DIN * DM, scr, r % I_IN, lane); continue; } r -= 2 * I_IN;
            if (r < 2 * I_OUT) { const int l = r / I_OUT; p0_transpose_item(w_out + (size_t)l * DMIX * DM, DMIX, DM, WoutT + (size_t)l * DM * DMIX, scr, r % I_OUT, lane); continue; } r -= 2 * I_OUT;
            { const int l = r / I_PW; p0_transpose_item(conv_pw_w + (size_t)l * 512 * 512, 512, 512, PwT + (size_t)l * 512 * 512, scr, r % I_PW, lane); }
        }
        for (int i = gw * 64 + lane; i < 2 * 4 * 128 * 128 / 2; i += NGW * 64) { const f32x2 v = *(const f32x2*)(sgu_w + 2 * (size_t)i); ((unsigned*)SgW)[i] = cvt_pk_bf16(v[0], v[1]); }
        for (int m = gw; m < MTOK; m += NGW) row_update<false, false, true>(x + (size_t)m * DM, nullptr, nullptr, nullptr, pre_g, nullptr, H + (size_t)m * DM, lane);
    }
    GRID_BAR();

#pragma unroll 1
    for (int l = 0; l < DEPTH; ++l) {
        const float* xin = (l == 0) ? x : X1;
        float* xout = (l == DEPTH - 1) ? p.out : X1;
        {
            const bf16_t* W = WinT + (size_t)l * DIN * DM;
            { pg8::Gemm g{H, W, MTOK, DIN - 1024, DM}; pg8::StaticOrder S; S.init(MTOK, DIN - 1024, G, bx, 8, 4); pg8::EpiBf16 E{Z, DIN};
              pg8::gemm_phase<pg8::EpiBf16, pg8::StaticOrder>(lds, g, S, E); }
            { pg8::Gemm g{W + (size_t)OFF_V * DM, H, 1024, MTOK, DM}; pg8::StaticOrder S; S.init(1024, MTOK, G, bx, 1 << 30, 0); pg8::EpiBf16 E{VT, MTOK};
              pg8::gemm_phase<pg8::EpiBf16, pg8::StaticOrder>(lds, g, S, E); }
        }
        GRID_BAR();
        {
            { FRESH_IDS();
            for (int it = bx; it < 256; it += G)
                conv_item(lds, Z, PwT + (size_t)l * 512 * 512, conv_w + (size_t)l * 31 * 512, conv_b + l * 512, conv_ln_g + l * 512, conv_ln_b + l * 512, conv_pw_b + l * 512, YC, it, tid, wid, lane); }
            { FRESH_IDS();
            for (int it = bx; it < 256; it += G)
                sgu_item(lds, Z, SgW + (size_t)l * 4 * 128 * 128, sgu_ln_g + l * 512, sgu_ln_b + l * 512, sgu_b + l * 512, YC, it, wid, lane); }
            { FRESH_IDS();
            LAS float* rpbl = (LAS float*)lds;
            for (int i = tid; i < 8 * 15 * 31; i += 512) rpbl[i] = rpb[(size_t)l * 8 * 15 * 31 + i];
            __syncthreads();
            for (int wi = gw; wi < NB * 8 * 32 * 4; wi += NGW) {
                const int j = wi & 3, r = (wi >> 2) & 31, h = (wi >> 7) & 7, b = wi >> 10;
                attn_wave_item(Z, VT, rpbl, YC, b, h, r, j, lane);
            } }
        }
        GRID_BAR();
        {
            pg8::Gemm g{YC, WoutT + (size_t)l * DM * DMIX, MTOK, DM, DMIX}; pg8::StaticOrder S; S.init(MTOK, DM, G, bx, 1 << 30, 0); pg8::EpiF32Ssq E{Y, DM, SSQ};
            pg8::gemm_phase<pg8::EpiF32Ssq, pg8::StaticOrder>(lds, g, S, E);
        }
        GRID_BAR();
        if (l == 0) {
            FRESH_IDS();
            for (int m = gw; m < MTOK; m += NGW)
                row_update<true, true, true>(xin + (size_t)m * DM, Y + (size_t)m * DM, SSQ + (size_t)m * 32, post_g + l * DM, pre_g + (l + 1) * DM, xout + (size_t)m * DM, H + (size_t)m * DM, lane);
            GRID_BAR();
        } else {
            FRESH_IDS();
            for (int m = gw; m < MTOK; m += NGW)
                row_update<true, true, false>(xin + (size_t)m * DM, Y + (size_t)m * DM, SSQ + (size_t)m * 32, post_g + l * DM, nullptr, xout + (size_t)m * DM, nullptr, lane);
        }
    }
}

extern "C" void kernel_launch(void* const* d_in, const int* in_sizes, int n_in, void* d_out, int out_size, void* d_ws, size_t ws_size, hipStream_t stream) {
    static int grid_blocks = 0;
    if (grid_blocks == 0) {
        if (n_in != 16 || ws_size < WS_END) { fprintf(stderr, "kernel_launch: unexpected n_in %d / ws_size %zu\n", n_in, ws_size); grid_blocks = -1; return; }
        int dev = 0, cus = 0, per_cu = 0;
        hipGetDevice(&dev);
        hipDeviceGetAttribute(&cus, hipDeviceAttributeMultiprocessorCount, dev);
        if (hipFuncSetAttribute((const void*)fwd_megakernel, hipFuncAttributeMaxDynamicSharedMemorySize, LDS_BYTES) != hipSuccess) fprintf(stderr, "kernel_launch: hipFuncSetAttribute failed\n");
        if (hipOccupancyMaxActiveBlocksPerMultiprocessor(&per_cu, (const void*)fwd_megakernel, 512, LDS_BYTES) != hipSuccess || per_cu < 1) { fprintf(stderr, "kernel_launch: occupancy query says %d\n", per_cu); per_cu = 1; }
        (void)hipGetLastError();
        grid_blocks = cus * 1;
    }
    if (grid_blocks < 0) return;
    if (hipMemsetAsync((char*)d_ws + WS_CTL, 0, CTL_BYTES, stream) != hipSuccess) { fprintf(stderr, "kernel_launch: memset failed\n"); return; }
    Params p{};
    for (int i = 0; i < 16; ++i) p.in[i] = (const float*)d_in[i];
    p.out = (float*)d_out; p.ws = (unsigned char*)d_ws;
    void* args[] = {&p};
    hipError_t e = hipLaunchCooperativeKernel((const void*)fwd_megakernel, dim3(grid_blocks), dim3(512), args, LDS_BYTES, stream);
    if (e != hipSuccess) fprintf(stderr, "cooperative launch failed: %s (grid %d)\n", hipGetErrorString(e), grid_blocks);
}
```

```cpp
#include <hip/hip_runtime.h>
#include <hip/hip_cooperative_groups.h>
#include <cstdio>
namespace cg = cooperative_groups;

#define LAS __attribute__((address_space(3)))
typedef unsigned short bf16_t;
typedef short bf16x8 __attribute__((ext_vector_type(8)));
typedef float f32x4 __attribute__((ext_vector_type(4)));
typedef float f32x2 __attribute__((ext_vector_type(2)));
typedef unsigned u32x4 __attribute__((ext_vector_type(4)));
typedef unsigned u32x2 __attribute__((ext_vector_type(2)));

constexpr int DM = 2048, NB = 4, SEQ = 2048, MTOK = NB * SEQ, DEPTH = 2;
constexpr int DIN = 7168, DMIX = 2048;
constexpr int OFF_Q = 0, OFF_K = 1024, OFF_V = 2048, OFF_GA = 3072, OFF_UB = 4096, OFF_VB = 4608, OFF_GB = 5120, OFF_AC = 5632, OFF_BC = 6144, OFF_GC = 6656;
constexpr float EPS = 1e-6f;

constexpr size_t MiB = 1u << 20;
constexpr size_t WS_WIN = 0;
constexpr size_t WS_WOUT = 56 * MiB;
constexpr size_t WS_PW = 72 * MiB;
constexpr size_t WS_SGW = 73 * MiB;
constexpr size_t WS_SSQ = 74 * MiB;
constexpr size_t WS_CTL = 75 * MiB;
constexpr size_t CTL_BYTES = 16384;
constexpr size_t WS_H = 76 * MiB;
constexpr size_t WS_Z = 108 * MiB;
constexpr size_t WS_VT = 220 * MiB;
constexpr size_t WS_YC = 236 * MiB;
constexpr size_t WS_Y = 268 * MiB;
constexpr size_t WS_X1 = 332 * MiB;
constexpr size_t WS_END = 396 * MiB;

constexpr int LDS_BYTES = 147456;

__device__ __forceinline__ unsigned cvt_pk_bf16(float lo, float hi) { unsigned r; asm volatile("v_cvt_pk_bf16_f32 %0, %1, %2" : "=v"(r) : "v"(lo), "v"(hi)); return r; }
__device__ __forceinline__ float bf_lo(unsigned w) { return __uint_as_float(w << 16); }
__device__ __forceinline__ float bf_hi(unsigned w) { return __uint_as_float(w & 0xffff0000u); }
__device__ __forceinline__ float wave_sum(float v) {
#pragma unroll
    for (int o = 1; o < 64; o <<= 1) v += __shfl_xor(v, o);
    return v;
}
__device__ __forceinline__ float gelu_f(float v) {
    const float av = fabsf(v), t = __builtin_amdgcn_rcpf(av * 0.2316418882f + 1.0f);
    float q = t * 0.5307027145f + (-0.7265760135f); q = q * t + 0.7107068705f; q = q * t + (-0.142248368f); q = q * t + 0.127414796f; q = q * t;
    const float e = __builtin_amdgcn_exp2f((v * v) * (-0.72134752044f));
    const float m = v * (q * e);
    return v < 0.f ? m : v - m;
}
__device__ __forceinline__ float sigmoid_f(float v) { return __builtin_amdgcn_rcpf(1.0f + __expf(-v)); }
__device__ __forceinline__ float silu_f(float v) { return v * __builtin_amdgcn_rcpf(1.0f + __expf(-v)); }
#define LDS_WAIT() asm volatile("s_waitcnt lgkmcnt(0)" ::: "memory")

namespace pg8 {
constexpr int BM = 256, BK = 64, HALF = 128, HTB = HALF * BK * 2, STAGE_BYTES = 8 * HTB, NXCD = 8, WGM = 8;
__device__ __forceinline__ int lds_byte(int r, int c) { const int st = (r >> 4) * 2 + (c >> 5), rr = r & 15, cc = c & 31, ob = rr * 64 + cc * 2; return st * 1024 + (ob ^ (((ob >> 9) & 1) << 5)); }
__device__ __forceinline__ void stage_rc(int b, int& R, int& C) { const int st = b / 1024, sb = b % 1024, swz = sb ^ (((sb >> 9) & 1) << 5); R = (st >> 1) * 16 + swz / 64; C = (st & 1) * 32 + (swz % 64) / 2; }
__device__ __forceinline__ int perm32(int rho) { const int n = rho >> 4, i = rho & 15; return 8 * (i >> 2) + 4 * n + (i & 3); }

struct Unit { int pm, pn; };
struct Gemm { const bf16_t* A; const bf16_t* Bt; int M, N, K; };

struct StaticOrder {
    int nM, nN, nwg, G, c, skip_from, skip;
    __device__ void init(int M, int N, int G_, int c_, int skip_from_, int skip_) { nM = M / BM; nN = N / BM; nwg = nM * nN; G = G_; c = c_; skip_from = skip_from_; skip = skip_; }
    __device__ bool next(int i, Unit& u) const {
        const long L = (long)i * G + c; if (L >= nwg) return false;
        int wgid = (int)L; { const int q = nwg / NXCD, r = nwg % NXCD, xcd = wgid % NXCD, off = wgid / NXCD; wgid = (xcd < r ? xcd * (q + 1) : r * (q + 1) + (xcd - r) * q) + off; }
        const int nig = WGM * nN, gid = wgid / nig, fm = gid * WGM, gsz = (nM - fm) < WGM ? (nM - fm) : WGM;
        u.pm = fm + ((wgid % nig) % gsz); u.pn = (wgid % nig) / gsz;
        if (u.pn >= skip_from) u.pn += skip;
        return true;
    }
    __device__ __forceinline__ void a_ready(const Unit&) const {}
    __device__ __forceinline__ void done(const Unit&) const {}
};

struct EpiBf16 {
    static constexpr bool PERM = true;
    bf16_t* O; int ldc;
    __device__ __forceinline__ void operator()(const f32x4 (&acc)[2][2][4][2], const Unit& u, int wr, int wc, int fr, int fq) const {
        const int row0 = u.pm * BM + wr * 64 + fr; const int col0 = u.pn * BM + wc * 32 + 8 * fq;
#pragma unroll
        for (int ai = 0; ai < 2; ++ai)
#pragma unroll
            for (int m = 0; m < 4; ++m) { bf16_t* rowp = O + (size_t)(row0 + ai * HALF + m * 16) * ldc + col0;
#pragma unroll
                for (int bj = 0; bj < 2; ++bj) { const f32x4 v0 = acc[ai][bj][m][0], v1 = acc[ai][bj][m][1];
                    u32x4 w; w.x = cvt_pk_bf16(v0[0], v0[1]); w.y = cvt_pk_bf16(v0[2], v0[3]); w.z = cvt_pk_bf16(v1[0], v1[1]); w.w = cvt_pk_bf16(v1[2], v1[3]);
                    *(u32x4*)(rowp + bj * HALF) = w; } }
    }
};
struct EpiF32Ssq {
    static constexpr bool PERM = false;
    float* C; int ldc; float* ssq;
    __device__ __forceinline__ void operator()(const f32x4 (&acc)[2][2][4][2], const Unit& u, int wr, int wc, int fr, int fq) const {
        const int row0 = u.pm * BM + wr * 64 + fr, col0 = u.pn * BM + wc * 32 + 4 * fq;
#pragma unroll
        for (int ai = 0; ai < 2; ++ai)
#pragma unroll
            for (int m = 0; m < 4; ++m) { const int row = row0 + ai * HALF + m * 16; float* rowp = C + (size_t)row * ldc + col0; float s = 0.f;
#pragma unroll
                for (int bj = 0; bj < 2; ++bj)
#pragma unroll
                    for (int n = 0; n < 2; ++n) { const f32x4 v = acc[ai][bj][m][n]; *(f32x4*)(rowp + bj * HALF + n * 16) = v; s += (v[0] * v[0] + v[1] * v[1]) + (v[2] * v[2] + v[3] * v[3]); }
                s += __shfl_xor(s, 16); s += __shfl_xor(s, 32);
                if (fq == 0) ssq[(size_t)row * 32 + u.pn * 4 + wc] = s; }
    }
};

template <class Epi, class Sched>
__device__ __forceinline__ void gemm_phase(LAS unsigned char* lds, const Gemm g, const Sched& S, const Epi& E) {
    int tid = threadIdx.x; asm volatile("" : "+v"(tid));
    const int wid = __builtin_amdgcn_readfirstlane(tid >> 6), lane = tid & 63, wr = wid >> 2, wc = wid & 3, fr = lane & 15, fq = lane >> 4;
    const int K = g.K, nt = K / BK;
    unsigned voffA[2], voffB[2];
#pragma unroll
    for (int i = 0; i < 2; ++i) { int R, C; stage_rc(tid * 16 + i * 8192, R, C); const int Rb = Epi::PERM ? ((R & ~31) + perm32(R & 31)) : R;
        voffA[i] = (unsigned)(R * K + C) * 2u; voffB[i] = (unsigned)(Rb * K + C) * 2u; }
    const size_t kstep = (size_t)(BK * 2);
    const size_t hstep = (size_t)HALF * K * 2;
    const size_t tstep = 2 * hstep;
    const unsigned ldsw = (unsigned)wid * 1024u;
    const int aoff = lds_byte(wr * 64 + fr, fq * 8), boff = lds_byte(wc * 32 + fr, fq * 8);
#define PG8_SA(b, h) (((b) * 2 + (h)) * HTB)
#define PG8_SB(b, h) ((4 + (b) * 2 + (h)) * HTB)
#define PG8_STAGE(bufoff, gbase, voff) do { _Pragma("unroll") for (int _i = 0; _i < 2; ++_i) \
        __builtin_amdgcn_global_load_lds((const unsigned*)((const char*)(gbase) + (voff)[_i]), (LAS unsigned*)(lds + (bufoff) + ldsw + _i * 8192), 16, 0, 0); } while (0)
#define PG8_LDA(dst, b, h) do { _Pragma("unroll") for (int m = 0; m < 4; ++m) _Pragma("unroll") for (int k = 0; k < 2; ++k) dst[m][k] = *(const LAS bf16x8*)(lds + PG8_SA(b, h) + aoff + m * 2048 + k * 1024); } while (0)
#define PG8_LDB(dst, b, h) do { _Pragma("unroll") for (int n = 0; n < 2; ++n) _Pragma("unroll") for (int k = 0; k < 2; ++k) dst[n][k] = *(const LAS bf16x8*)(lds + PG8_SB(b, h) + boff + n * 2048 + k * 1024); } while (0)
#define PG8_MMA(ai, bj, At, Bt) do { __builtin_amdgcn_s_setprio(1); _Pragma("unroll") for (int m = 0; m < 4; ++m) _Pragma("unroll") for (int n = 0; n < 2; ++n) _Pragma("unroll") for (int k = 0; k < 2; ++k) \
        acc[ai][bj][m][n] = __builtin_amdgcn_mfma_f32_16x16x32_bf16(Bt[n][k], At[m][k], acc[ai][bj][m][n], 0, 0, 0); __builtin_amdgcn_s_setprio(0); } while (0)
#define PG8_WAIT_V(n) asm volatile("s_waitcnt vmcnt(" #n ")" ::: "memory")
#define PG8_WAIT_L(n) asm volatile("s_waitcnt lgkmcnt(" #n ")" ::: "memory")
#define PG8_BAR __builtin_amdgcn_s_barrier()
#define PG8_SCHED __builtin_amdgcn_sched_barrier(0)
    Unit cur, nxt; int ui = 0;
    if (!S.next(0, cur)) return;
    f32x4 acc[2][2][4][2];
#pragma unroll
    for (int a = 0; a < 2; ++a)
#pragma unroll
        for (int b = 0; b < 2; ++b)
#pragma unroll
            for (int m = 0; m < 4; ++m)
#pragma unroll
                for (int n = 0; n < 2; ++n) acc[a][b][m][n] = (f32x4){0.f, 0.f, 0.f, 0.f};
    bf16x8 At[4][2], B0[2][2], B1[2][2];
    const char* cA = (const char*)g.A + (size_t)cur.pm * tstep; const char* cB = (const char*)g.Bt + (size_t)cur.pn * tstep;
    S.a_ready(cur);
    PG8_STAGE(PG8_SB(0, 0), cB, voffB); PG8_STAGE(PG8_SA(0, 0), cA, voffA); PG8_STAGE(PG8_SB(0, 1), cB + hstep, voffB); PG8_STAGE(PG8_SA(0, 1), cA + hstep, voffA);
    if (wr == 1) PG8_BAR;
    PG8_WAIT_V(4); PG8_BAR;
    PG8_STAGE(PG8_SB(1, 0), cB + kstep, voffB); PG8_STAGE(PG8_SA(1, 0), cA + kstep, voffA); PG8_STAGE(PG8_SB(1, 1), cB + hstep + kstep, voffB);
    PG8_WAIT_V(6); PG8_BAR;
    for (;;) {
        const bool has_next = S.next(ui + 1, nxt);
        const char* nA = has_next ? (const char*)g.A + (size_t)nxt.pm * tstep : cA; const char* nB = has_next ? (const char*)g.Bt + (size_t)nxt.pn * tstep : cB;
        for (int t = 0; t < nt; t += 2) {
            const bool last = (t == nt - 2);
            const char* a1 = cA + (size_t)(t + 1) * kstep;
            const char* a2 = last ? nA : cA + (size_t)(t + 2) * kstep; const char* b2 = last ? nB : cB + (size_t)(t + 2) * kstep;
            const char* a3 = a2 + kstep; const char* b3 = b2 + kstep;
            if (last && has_next) S.a_ready(nxt);
            PG8_LDB(B0, 0, 0); PG8_SCHED; PG8_LDA(At, 0, 0); PG8_STAGE(PG8_SA(1, 1), a1 + hstep, voffA);
            PG8_WAIT_L(8); PG8_BAR; PG8_WAIT_L(0); PG8_MMA(0, 0, At, B0); PG8_BAR; PG8_SCHED;
            PG8_LDB(B1, 0, 1); PG8_STAGE(PG8_SB(0, 0), b2, voffB);
            PG8_BAR; PG8_WAIT_L(0); PG8_MMA(0, 1, At, B1); PG8_BAR;
            PG8_LDA(At, 0, 1); PG8_STAGE(PG8_SA(0, 0), a2, voffA);
            PG8_BAR; PG8_WAIT_L(0); PG8_MMA(1, 0, At, B0); PG8_BAR; PG8_SCHED;
            PG8_STAGE(PG8_SB(0, 1), b2 + hstep, voffB);
            PG8_WAIT_V(6); PG8_BAR; PG8_MMA(1, 1, At, B1); PG8_BAR;
            PG8_LDB(B0, 1, 0); PG8_SCHED; PG8_LDA(At, 1, 0); PG8_STAGE(PG8_SA(0, 1), a2 + hstep, voffA);
            PG8_WAIT_L(8); PG8_BAR; PG8_WAIT_L(0); PG8_MMA(0, 0, At, B0); PG8_BAR; PG8_SCHED;
            PG8_LDB(B1, 1, 1); PG8_STAGE(PG8_SB(1, 0), b3, voffB);
            PG8_BAR; PG8_WAIT_L(0); PG8_MMA(0, 1, At, B1); PG8_BAR;
            PG8_LDA(At, 1, 1); PG8_STAGE(PG8_SA(1, 0), a3, voffA);
            PG8_BAR; PG8_WAIT_L(0); PG8_MMA(1, 0, At, B0); PG8_BAR; PG8_SCHED;
            PG8_STAGE(PG8_SB(1, 1), b3 + hstep, voffB);
            PG8_WAIT_V(6); PG8_BAR; PG8_MMA(1, 1, At, B1); PG8_BAR;
        }
        E(acc, cur, wr, wc, fr, fq); S.done(cur);
        if (!has_next) break;
#pragma unroll
        for (int a = 0; a < 2; ++a)
#pragma unroll
            for (int b = 0; b < 2; ++b)
#pragma unroll
                for (int m = 0; m < 4; ++m)
#pragma unroll
                    for (int n = 0; n < 2; ++n) acc[a][b][m][n] = (f32x4){0.f, 0.f, 0.f, 0.f};
        cur = nxt; cA = nA; cB = nB; ++ui;
    }
    PG8_WAIT_V(0);
    if (wr == 0) PG8_BAR;
    PG8_BAR;
#undef PG8_SA
#undef PG8_SB
#undef PG8_STAGE
#undef PG8_LDA
#undef PG8_LDB
#undef PG8_MMA
#undef PG8_WAIT_V
#undef PG8_WAIT_L
#undef PG8_BAR
#undef PG8_SCHED
}
}

__device__ __forceinline__ void p0_transpose_item(const float* W, int K, int N, bf16_t* WT, LAS float* scr, int item, int lane) {
    const int nblk = N / 32, kb = item / nblk, nb = item % nblk, k0 = 64 * kb, n0 = 32 * nb;
    float tv[32];
#pragma unroll
    for (int i = 0; i < 32; ++i) { const int kk = 2 * i + (lane >> 5); tv[i] = W[(size_t)(k0 + kk) * N + n0 + (lane & 31)]; }
#pragma unroll
    for (int i = 0; i < 32; ++i) { const int kk = 2 * i + (lane >> 5); scr[kk * 33 + (lane & 31)] = tv[i]; }
    LDS_WAIT(); asm volatile("" ::: "memory");
    const int c = lane & 7;
#pragma unroll
    for (int j = 0; j < 4; ++j) { const int n = (lane >> 3) + 8 * j; const LAS float* s = scr + (8 * c) * 33 + n;
        u32x4 o; o.x = cvt_pk_bf16(s[0 * 33], s[1 * 33]); o.y = cvt_pk_bf16(s[2 * 33], s[3 * 33]); o.z = cvt_pk_bf16(s[4 * 33], s[5 * 33]); o.w = cvt_pk_bf16(s[6 * 33], s[7 * 33]);
        *(u32x4*)(WT + (size_t)(n0 + n) * K + k0 + 8 * c) = o; }
    LDS_WAIT(); asm volatile("" ::: "memory");
}

template <bool HAS_Y, bool WRITE_X, bool WRITE_H>
__device__ __forceinline__ void row_update(const float* xrow, const float* yrow, const float* ssq_row, const float* gpost, const float* gpre, float* xout, bf16_t* hout, int lane) {
    f32x4 v[8];
    const f32x4* xr = (const f32x4*)xrow + lane;
#pragma unroll
    for (int j = 0; j < 8; ++j) v[j] = xr[64 * j];
    if (HAS_Y) {
        float s = ssq_row[lane & 31];
#pragma unroll
        for (int o = 1; o < 32; o <<= 1) s += __shfl_xor(s, o);
        const float rstd = 1.0f / sqrtf(s * (1.0f / DM) + EPS);
        const f32x4* yr = (const f32x4*)yrow + lane; const f32x4* gp = (const f32x4*)gpost + lane;
#pragma unroll
        for (int j = 0; j < 8; ++j) { const f32x4 y = yr[64 * j], g = gp[64 * j]; v[j] = v[j] + (y * rstd) * g; }
    }
    if (WRITE_X) { f32x4* xo = (f32x4*)xout + lane;
#pragma unroll
        for (int j = 0; j < 8; ++j) xo[64 * j] = v[j]; }
    if (WRITE_H) {
        float s2 = 0.f;
#pragma unroll
        for (int j = 0; j < 8; ++j) s2 += (v[j][0] * v[j][0] + v[j][1] * v[j][1]) + (v[j][2] * v[j][2] + v[j][3] * v[j][3]);
        const float rstd2 = 1.0f / sqrtf(wave_sum(s2) * (1.0f / DM) + EPS);
        const f32x4* gq = (const f32x4*)gpre + lane; u32x2* ho = (u32x2*)hout + lane;
#pragma unroll
        for (int j = 0; j < 8; ++j) { const f32x4 g = gq[64 * j]; u32x2 w; w.x = cvt_pk_bf16(v[j][0] * rstd2 * g[0], v[j][1] * rstd2 * g[1]); w.y = cvt_pk_bf16(v[j][2] * rstd2 * g[2], v[j][3] * rstd2 * g[3]); ho[64 * j] = w; }
    }
}

#define SCHED_BAR() __builtin_amdgcn_sched_barrier(0)
__device__ __forceinline__ void attn_wave_item(const bf16_t* Z, const bf16_t* VT, const LAS float* rpbl, bf16_t* YC, int b, int h, int r, int j, int lane) {
    const int fr = lane & 15, fq = lane >> 4;
    const int rs = min(max(r - 4, 0), 24);
    const int kc0 = (j == 0) ? 0 : (j == 1) ? 8 : (j == 2) ? 24 : 32;
    const int w = j * 16 + fr;
    const int tokq = b * SEQ + r * 64 + w;
    const int cs = min(max(w - 8, 0), 48);
    bf16x8 qf[4];
    { const bf16_t* qp = Z + (size_t)tokq * DIN + OFF_Q + h * 128 + 8 * fq;
#pragma unroll
      for (int s = 0; s < 4; ++s) qf[s] = *(const bf16x8*)(qp + 32 * s); }
    const int kcl = 8 * (fr >> 2) + (fr & 3);
    const bf16_t* kbase = Z + (size_t)(b * SEQ + rs * 64 + kc0 + kcl) * DIN + OFF_K + h * 128 + 8 * fq;
    bf16x8 kb[2][16];
#define ATT_LOADK(buf, bt) do { _Pragma("unroll") for (int ii = 0; ii < 2; ++ii) _Pragma("unroll") for (int hf = 0; hf < 2; ++hf) _Pragma("unroll") for (int s = 0; s < 4; ++s) \
        kb[buf][(ii * 2 + hf) * 4 + s] = *(const bf16x8*)(kbase + (size_t)((2 * (bt) + ii) * 64 + 4 * hf) * DIN + 32 * s); } while (0)
    f32x4 sacc[8][2];
    ATT_LOADK(0, 0);
#pragma unroll
    for (int bt = 0; bt < 4; ++bt) {
        if (bt < 3) ATT_LOADK((bt + 1) & 1, bt + 1);
        SCHED_BAR();
#pragma unroll
        for (int ii = 0; ii < 2; ++ii)
#pragma unroll
            for (int hf = 0; hf < 2; ++hf) {
                f32x4 a = (f32x4){0.f, 0.f, 0.f, 0.f};
#pragma unroll
                for (int s = 0; s < 4; ++s) a = __builtin_amdgcn_mfma_f32_16x16x32_bf16(kb[bt & 1][(ii * 2 + hf) * 4 + s], qf[s], a, 0, 0, 0);
                sacc[2 * bt + ii][hf] = a;
            }
        SCHED_BAR();
    }
#undef ATT_LOADK
    const bf16_t* vbase = VT + (size_t)(h * 128 + fr) * MTOK + b * SEQ + rs * 64 + kc0 + 8 * fq;
    bf16x8 vb[2][16];
#define ATT_LOADV(buf, bt) do { _Pragma("unroll") for (int ii = 0; ii < 2; ++ii) _Pragma("unroll") for (int dt = 0; dt < 8; ++dt) \
        vb[buf][ii * 8 + dt] = *(const bf16x8*)(vbase + (size_t)(16 * dt) * MTOK + (2 * (bt) + ii) * 64); } while (0)
    ATT_LOADV(0, 0);
    SCHED_BAR();
    const float scale = 0.08838834764831845f;
    const LAS float* rp = rpbl + h * (15 * 31);
    float mx = -1e30f;
#pragma unroll
    for (int i = 0; i < 8; ++i) {
        const int dr = rs + i - r + 7;
#pragma unroll
        for (int hf = 0; hf < 2; ++hf)
#pragma unroll
            for (int rg = 0; rg < 4; ++rg) {
                const int kc = kc0 + 8 * fq + 4 * hf + rg;
                const bool valid = (kc >= cs) && (kc < cs + 16);
                const int dc = min(max(kc - w + 15, 0), 30);
                const float sv = sacc[i][hf][rg] * scale + rp[dr * 31 + dc];
                sacc[i][hf][rg] = valid ? sv : -1e30f;
                mx = fmaxf(mx, sacc[i][hf][rg]);
            }
    }
    mx = fmaxf(mx, __shfl_xor(mx, 16)); mx = fmaxf(mx, __shfl_xor(mx, 32));
    float sum = 0.f;
    bf16x8 pf[8];
#pragma unroll
    for (int i = 0; i < 8; ++i) {
        float pv[8];
#pragma unroll
        for (int hf = 0; hf < 2; ++hf)
#pragma unroll
            for (int rg = 0; rg < 4; ++rg) { const float sv = sacc[i][hf][rg]; const float pe = (sv > -1e29f) ? __expf(sv - mx) : 0.f; pv[hf * 4 + rg] = pe; sum += pe; }
        u32x4 pk; pk.x = cvt_pk_bf16(pv[0], pv[1]); pk.y = cvt_pk_bf16(pv[2], pv[3]); pk.z = cvt_pk_bf16(pv[4], pv[5]); pk.w = cvt_pk_bf16(pv[6], pv[7]);
        pf[i] = __builtin_bit_cast(bf16x8, pk);
    }
    sum += __shfl_xor(sum, 16); sum += __shfl_xor(sum, 32);
    const float inv = __builtin_amdgcn_rcpf(sum);
    f32x4 oacc[8];
#pragma unroll
    for (int dt = 0; dt < 8; ++dt) oacc[dt] = (f32x4){0.f, 0.f, 0.f, 0.f};
    const bf16_t* gp = Z + (size_t)tokq * DIN + OFF_GA + h * 128 + 4 * fq;
    u32x2 gwv[8];
#pragma unroll
    for (int bt = 0; bt < 4; ++bt) {
        if (bt < 3) ATT_LOADV((bt + 1) & 1, bt + 1);
        else {
#pragma unroll
            for (int dt = 0; dt < 8; ++dt) gwv[dt] = *(const u32x2*)(gp + 16 * dt);
        }
        SCHED_BAR();
#pragma unroll
        for (int ii = 0; ii < 2; ++ii)
#pragma unroll
            for (int dt = 0; dt < 8; ++dt) oacc[dt] = __builtin_amdgcn_mfma_f32_16x16x32_bf16(vb[bt & 1][ii * 8 + dt], pf[2 * bt + ii], oacc[dt], 0, 0, 0);
        SCHED_BAR();
    }
#undef ATT_LOADV
    bf16_t* op = YC + (size_t)tokq * DMIX + h * 128 + 4 * fq;
#pragma unroll
    for (int dt = 0; dt < 8; ++dt) {
        const u32x2 gw = gwv[dt];
        const float g0 = silu_f(bf_lo(gw.x)), g1 = silu_f(bf_hi(gw.x)), g2 = silu_f(bf_lo(gw.y)), g3 = silu_f(bf_hi(gw.y));
        u32x2 o; o.x = cvt_pk_bf16(oacc[dt][0] * inv * g0, oacc[dt][1] * inv * g1); o.y = cvt_pk_bf16(oacc[dt][2] * inv * g2, oacc[dt][3] * inv * g3);
        *(u32x2*)(op + 16 * dt) = o;
    }
}

constexpr int SGU_ROWB = 272;
__device__ __forceinline__ void sgu_item(LAS unsigned char* lds, const bf16_t* Z, const bf16_t* SGW, const float* ln_g, const float* ln_b, const float* b_s, bf16_t* YC, int item, int wid, int lane) {
    const int g = item & 3, bn = item >> 2;
    const int tk0 = bn * 128;
    const int fr = lane & 15, fq = lane >> 4;
    float lg[8], lb[8];
    { const f32x4* gp4 = (const f32x4*)(ln_g + 8 * lane); const f32x4* bp4 = (const f32x4*)(ln_b + 8 * lane); const f32x4 a0 = gp4[0], a1 = gp4[1], c0 = bp4[0], c1 = bp4[1];
      lg[0] = a0[0]; lg[1] = a0[1]; lg[2] = a0[2]; lg[3] = a0[3]; lg[4] = a1[0]; lg[5] = a1[1]; lg[6] = a1[2]; lg[7] = a1[3];
      lb[0] = c0[0]; lb[1] = c0[1]; lb[2] = c0[2]; lb[3] = c0[3]; lb[4] = c1[0]; lb[5] = c1[1]; lb[6] = c1[2]; lb[7] = c1[3]; }
#pragma unroll 1
    for (int hb = 0; hb < 2; ++hb) {
        u32x4 raw[8];
#pragma unroll
        for (int q = 0; q < 8; ++q) raw[q] = *(const u32x4*)(Z + (size_t)(tk0 + 16 * wid + 8 * hb + q) * DIN + OFF_VB + 8 * lane);
        SCHED_BAR();
        float x[8][8], sm[8];
#pragma unroll
        for (int q = 0; q < 8; ++q) {
            x[q][0] = bf_lo(raw[q].x); x[q][1] = bf_hi(raw[q].x); x[q][2] = bf_lo(raw[q].y); x[q][3] = bf_hi(raw[q].y); x[q][4] = bf_lo(raw[q].z); x[q][5] = bf_hi(raw[q].z); x[q][6] = bf_lo(raw[q].w); x[q][7] = bf_hi(raw[q].w);
            float a = 0.f;
#pragma unroll
            for (int e = 0; e < 8; ++e) { x[q][e] = gelu_f(x[q][e]); a += x[q][e]; }
            sm[q] = a;
        }
#pragma unroll
        for (int o = 1; o < 64; o <<= 1)
#pragma unroll
            for (int q = 0; q < 8; ++q) sm[q] += __shfl_xor(sm[q], o);
        float sq[8];
#pragma unroll
        for (int q = 0; q < 8; ++q) { const float mean = sm[q] * (1.0f / 512.0f); float a = 0.f;
#pragma unroll
            for (int e = 0; e < 8; ++e) { x[q][e] -= mean; a += x[q][e] * x[q][e]; }
            sq[q] = a; }
#pragma unroll
        for (int o = 1; o < 64; o <<= 1)
#pragma unroll
            for (int q = 0; q < 8; ++q) sq[q] += __shfl_xor(sq[q], o);
        if ((lane >> 4) == g) {
            const int cl = 8 * (lane & 15);
#pragma unroll
            for (int q = 0; q < 8; ++q) { const float rstd = 1.0f / sqrtf(sq[q] * (1.0f / 512.0f) + EPS); const int s = 16 * wid + 8 * hb + q;
#pragma unroll
                for (int e = 0; e < 8; ++e) { const float y = x[q][e] * rstd * lg[e] + lb[e]; *(LAS bf16_t*)(lds + (cl + e) * SGU_ROWB + s * 2) = (bf16_t)(cvt_pk_bf16(y, 0.f) & 0xffffu); } }
        }
    }
    const int t = 16 * wid + fr, tok = tk0 + t;
    const bf16_t* zr = Z + (size_t)tok * DIN + g * 128 + 4 * fq;
    u32x2 uwv[8], gwv[8];
#pragma unroll
    for (int ct = 0; ct < 8; ++ct) { uwv[ct] = *(const u32x2*)(zr + OFF_UB + 16 * ct); gwv[ct] = *(const u32x2*)(zr + OFF_GB + 16 * ct); }
    const float bs = b_s[g * 128 + t];
    bf16x8 wf[4];
    { const bf16_t* wp = SGW + (size_t)(g * 128 + 16 * wid + fr) * 128 + 8 * fq;
#pragma unroll
      for (int ks = 0; ks < 4; ++ks) wf[ks] = *(const bf16x8*)(wp + 32 * ks); }
    __syncthreads();
    f32x4 acc[8];
#pragma unroll
    for (int ct = 0; ct < 8; ++ct) {
        f32x4 a = (f32x4){0.f, 0.f, 0.f, 0.f};
#pragma unroll
        for (int ks = 0; ks < 4; ++ks) { const bf16x8 vf = *(const LAS bf16x8*)(lds + (16 * ct + fr) * SGU_ROWB + (32 * ks + 8 * fq) * 2); a = __builtin_amdgcn_mfma_f32_16x16x32_bf16(vf, wf[ks], a, 0, 0, 0); }
        acc[ct] = a;
    }
    bf16_t* op = YC + (size_t)tok * DMIX + 1024 + g * 128 + 4 * fq;
#pragma unroll
    for (int ct = 0; ct < 8; ++ct) {
        const u32x2 uw = uwv[ct], gw = gwv[ct];
        const float u0 = gelu_f(bf_lo(uw.x)), u1 = gelu_f(bf_hi(uw.x)), u2 = gelu_f(bf_lo(uw.y)), u3 = gelu_f(bf_hi(uw.y));
        const float g0 = silu_f(bf_lo(gw.x)), g1 = silu_f(bf_hi(gw.x)), g2 = silu_f(bf_lo(gw.y)), g3 = silu_f(bf_hi(gw.y));
        u32x2 o; o.x = cvt_pk_bf16(u0 * (acc[ct][0] + bs) * g0, u1 * (acc[ct][1] + bs) * g1); o.y = cvt_pk_bf16(u2 * (acc[ct][2] + bs) * g2, u3 * (acc[ct][3] + bs) * g3);
        *(u32x2*)(op + 16 * ct) = o;
    }
    __syncthreads();
}

constexpr int CV_G_OFF = 0, CV_G_ROWS = 62, CV_C_OFF = 63488, CV_A_ROWB = 1040;
__device__ __forceinline__ unsigned glu_pk(unsigned a, unsigned b) { return cvt_pk_bf16(bf_lo(a) * sigmoid_f(bf_lo(b)), bf_hi(a) * sigmoid_f(bf_hi(b))); }
__device__ __forceinline__ void conv_item(LAS unsigned char* lds, const bf16_t* Z, const bf16_t* PWT, const float* cw, const float* cb, const float* ln_g, const float* ln_b, const float* pwb, bf16_t* YC, int item, int tid, int wid, int lane) {
    const int b = item >> 6, t0 = (item & 63) * 32;
#define REOPAQUE() do { asm volatile("" : "+v"(tid)); lane = tid & 63; fr = lane & 15; fq = lane >> 4; } while (0)
    int fr, fq;
    REOPAQUE();
#pragma unroll 1
    for (int ps = 0; ps < 2; ++ps) {
        u32x4 av[4], bv[4]; bool ok[4];
#pragma unroll
        for (int q = 0; q < 4; ++q) {
            const int wk = tid + 512 * (4 * ps + q), tt = wk >> 6, c8 = (wk & 63) * 8, pp = t0 - 15 + tt;
            ok[q] = (tt < CV_G_ROWS) && (pp >= 0) && (pp < SEQ);
            av[q] = (u32x4){0u, 0u, 0u, 0u}; bv[q] = (u32x4){0u, 0u, 0u, 0u};
            if (ok[q]) { const bf16_t* zr = Z + (size_t)(b * SEQ + pp) * DIN + c8; av[q] = *(const u32x4*)(zr + OFF_AC); bv[q] = *(const u32x4*)(zr + OFF_BC); }
        }
        SCHED_BAR();
#pragma unroll
        for (int q = 0; q < 4; ++q) {
            const int wk = tid + 512 * (4 * ps + q), tt = wk >> 6, c8 = (wk & 63) * 8;
            u32x4 o; o.x = glu_pk(av[q].x, bv[q].x); o.y = glu_pk(av[q].y, bv[q].y); o.z = glu_pk(av[q].z, bv[q].z); o.w = glu_pk(av[q].w, bv[q].w);
            if (tt < CV_G_ROWS) *(LAS u32x4*)(lds + CV_G_OFF + tt * 1024 + c8 * 2) = o;
        }
    }
    __syncthreads();
    REOPAQUE();
    {
        const int cp = tid & 255, th = tid >> 8;
        float w0[31], w1[31];
#pragma unroll
        for (int jj = 0; jj < 31; ++jj) { const f32x2 wv = *(const f32x2*)(cw + jj * 512 + 2 * cp); w0[jj] = wv[0]; w1[jj] = wv[1]; }
        const f32x2 bias = *(const f32x2*)(cb + 2 * cp);
        float a0[16], a1[16];
#pragma unroll
        for (int o = 0; o < 16; ++o) { a0[o] = bias[0]; a1[o] = bias[1]; }
#pragma unroll
        for (int tl = 0; tl < 46; ++tl) {
            const unsigned gv = *(const LAS unsigned*)(lds + CV_G_OFF + (16 * th + tl) * 1024 + cp * 4);
            const float h0 = bf_lo(gv), h1 = bf_hi(gv);
#pragma unroll
            for (int o = 0; o < 16; ++o) { const int jj = tl - o; if (jj >= 0 && jj <= 30) { a0[o] += h0 * w0[jj]; a1[o] += h1 * w1[jj]; } }
        }
#pragma unroll
        for (int o = 0; o < 16; ++o) *(LAS f32x2*)(lds + CV_C_OFF + (16 * th + o) * 2048 + cp * 8) = (f32x2){a0[o], a1[o]};
    }
    __syncthreads();
    REOPAQUE();
    const bf16_t* pw = PWT + (size_t)(64 * wid + fr) * 512 + 8 * fq;
    bf16x8 pfb[2][4];
#pragma unroll
    for (int nt = 0; nt < 4; ++nt) pfb[0][nt] = *(const bf16x8*)(pw + (size_t)(16 * nt) * 512);
    {
        const f32x4 g0 = *(const f32x4*)(ln_g + 8 * lane), g1 = *(const f32x4*)(ln_g + 8 * lane + 4), b0 = *(const f32x4*)(ln_b + 8 * lane), b1 = *(const f32x4*)(ln_b + 8 * lane + 4);
        f32x4 x0[4], x1[4]; float sm[4], sq[4];
#pragma unroll
        for (int q = 0; q < 4; ++q) { const int t = 4 * wid + q;
            x0[q] = *(const LAS f32x4*)(lds + CV_C_OFF + t * 2048 + lane * 32); x1[q] = *(const LAS f32x4*)(lds + CV_C_OFF + t * 2048 + lane * 32 + 16);
            sm[q] = (x0[q][0] + x0[q][1]) + (x0[q][2] + x0[q][3]) + (x1[q][0] + x1[q][1]) + (x1[q][2] + x1[q][3]); }
#pragma unroll
        for (int o = 1; o < 64; o <<= 1)
#pragma unroll
            for (int q = 0; q < 4; ++q) sm[q] += __shfl_xor(sm[q], o);
#pragma unroll
        for (int q = 0; q < 4; ++q) { const float mean = sm[q] * (1.0f / 512.0f); x0[q] = x0[q] - mean; x1[q] = x1[q] - mean;
            sq[q] = (x0[q][0] * x0[q][0] + x0[q][1] * x0[q][1]) + (x0[q][2] * x0[q][2] + x0[q][3] * x0[q][3]) + (x1[q][0] * x1[q][0] + x1[q][1] * x1[q][1]) + (x1[q][2] * x1[q][2] + x1[q][3] * x1[q][3]); }
#pragma unroll
        for (int o = 1; o < 64; o <<= 1)
#pragma unroll
            for (int q = 0; q < 4; ++q) sq[q] += __shfl_xor(sq[q], o);
#pragma unroll
        for (int q = 0; q < 4; ++q) { const int t = 4 * wid + q;
            const float rstd = 1.0f / sqrtf(sq[q] * (1.0f / 512.0f) + EPS);
            const f32x4 y0 = x0[q] * rstd * g0 + b0, y1 = x1[q] * rstd * g1 + b1;
            u32x4 o; o.x = cvt_pk_bf16(silu_f(y0[0]), silu_f(y0[1])); o.y = cvt_pk_bf16(silu_f(y0[2]), silu_f(y0[3])); o.z = cvt_pk_bf16(silu_f(y1[0]), silu_f(y1[1])); o.w = cvt_pk_bf16(silu_f(y1[2]), silu_f(y1[3]));
            *(LAS u32x4*)(lds + t * CV_A_ROWB + lane * 16) = o; }
    }
    __syncthreads();
    {
        f32x4 acc[4][2];
#pragma unroll
        for (int nt = 0; nt < 4; ++nt) { acc[nt][0] = (f32x4){0.f, 0.f, 0.f, 0.f}; acc[nt][1] = (f32x4){0.f, 0.f, 0.f, 0.f}; }
#pragma unroll
        for (int ks = 0; ks < 16; ++ks) {
            if (ks < 15) {
#pragma unroll
                for (int nt = 0; nt < 4; ++nt) pfb[(ks + 1) & 1][nt] = *(const bf16x8*)(pw + (size_t)(16 * nt) * 512 + 32 * (ks + 1));
            }
            SCHED_BAR();
            bf16x8 af[2];
#pragma unroll
            for (int tt = 0; tt < 2; ++tt) af[tt] = *(const LAS bf16x8*)(lds + (16 * tt + fr) * CV_A_ROWB + (32 * ks + 8 * fq) * 2);
#pragma unroll
            for (int nt = 0; nt < 4; ++nt) {
                acc[nt][0] = __builtin_amdgcn_mfma_f32_16x16x32_bf16(pfb[ks & 1][nt], af[0], acc[nt][0], 0, 0, 0);
                acc[nt][1] = __builtin_amdgcn_mfma_f32_16x16x32_bf16(pfb[ks & 1][nt], af[1], acc[nt][1], 0, 0, 0); }
            SCHED_BAR();
        }
        REOPAQUE();
        u32x2 gwv[2][4]; f32x4 pbv[4];
#pragma unroll
        for (int nt = 0; nt < 4; ++nt) { const int n4 = 64 * wid + 16 * nt + 4 * fq; pbv[nt] = *(const f32x4*)(pwb + n4);
#pragma unroll
            for (int tt = 0; tt < 2; ++tt) gwv[tt][nt] = *(const u32x2*)(Z + (size_t)(b * SEQ + t0 + 16 * tt + fr) * DIN + OFF_GC + n4); }
        SCHED_BAR();
#pragma unroll
        for (int tt = 0; tt < 2; ++tt) {
            const int tok = b * SEQ + t0 + 16 * tt + fr;
#pragma unroll
            for (int nt = 0; nt < 4; ++nt) {
                const int n4 = 64 * wid + 16 * nt + 4 * fq;
                const f32x4 pb = pbv[nt]; const u32x2 gw = gwv[tt][nt];
                const float g0 = silu_f(bf_lo(gw.x)), g1 = silu_f(bf_hi(gw.x)), g2 = silu_f(bf_lo(gw.y)), g3 = silu_f(bf_hi(gw.y));
                u32x2 o; o.x = cvt_pk_bf16((acc[nt][tt][0] + pb[0]) * g0, (acc[nt][tt][1] + pb[1]) * g1); o.y = cvt_pk_bf16((acc[nt][tt][2] + pb[2]) * g2, (acc[nt][tt][3] + pb[3]) * g3);
                *(u32x2*)(YC + (size_t)tok * DMIX + 1536 + n4) = o;
            }
        }
    }
    __syncthreads();
#undef REOPAQUE
}

#define XB_TMO      128
#define XB_XCNT(j)  (256  + 64 * (j))
#define XB_XSUB(j)  (1280 + 64 * (j))
#define XB_XGEN(j)  (2304 + 64 * (j))
#define XB_TOP      3328
#define XB_TOPGEN   3392
#define XCD_BAR_WORDS 3456
#define XB_SPIN_CAP (1u << 18)

__device__ __forceinline__ unsigned xb_ld(unsigned* p)              { return __hip_atomic_load(p, __ATOMIC_RELAXED, __HIP_MEMORY_SCOPE_AGENT); }
__device__ __forceinline__ unsigned xb_add(unsigned* p, unsigned v) { return __hip_atomic_fetch_add(p, v, __ATOMIC_RELAXED, __HIP_MEMORY_SCOPE_AGENT); }
__device__ __forceinline__ unsigned xb_xcc_id() { return (unsigned)__builtin_amdgcn_s_getreg((3 << 11) | 20) & 0xFu; }
#define XB_SPIN(cond, bar) do { unsigned _sp = 0; while (cond) { __builtin_amdgcn_s_sleep(1); \
    if ((++_sp & 255u) == 0u) { if (xb_ld(&(bar)[XB_TMO])) break; if (_sp > XB_SPIN_CAP) { atomicAdd(&(bar)[XB_TMO], 1u); break; } } } } while (0)

struct XcdBarrier {
    unsigned* bar; unsigned x;
    volatile LAS unsigned* st;
};

__device__ __forceinline__ XcdBarrier xcd_barrier_post(unsigned* bar, volatile LAS unsigned* st) {
    XcdBarrier b; b.bar = bar; b.x = xb_xcc_id(); b.st = st;
    if (threadIdx.x == 0) (void)xb_add(&bar[XB_XCNT(b.x)], 1u);
    return b;
}
__device__ __forceinline__ void xcd_barrier_complete(unsigned* bar, unsigned x, unsigned& nloc, unsigned& nx) {
    const unsigned G = gridDim.x * gridDim.y * gridDim.z;
    unsigned sum, cnt, mine, sp = 0u;
    for (;;) {
        sum = 0u; cnt = 0u; mine = 0u;
#pragma unroll
        for (unsigned j = 0; j < 16; ++j) { const unsigned c = xb_ld(&bar[XB_XCNT(j)]); sum += c; cnt += (c > 0u) ? 1u : 0u; mine = (j == x) ? c : mine; }
        if (sum == G) break;
        __builtin_amdgcn_s_sleep(1);
        if ((++sp & 255u) == 0u) { if (xb_ld(&bar[XB_TMO])) break; if (sp > XB_SPIN_CAP) { atomicAdd(&bar[XB_TMO], 1u); break; } }
    }
    nloc = mine > 0u ? mine : 1u; nx = cnt > 0u ? cnt : 1u;
}

__device__ __forceinline__ void xcd_barrier(const XcdBarrier& b) {
    asm volatile("s_waitcnt vmcnt(0)" ::: "memory");
    __syncthreads();
    if (threadIdx.x == 0) {
        unsigned* bar = b.bar;
        __builtin_amdgcn_s_waitcnt(0);
        unsigned nloc = b.st[0], nx = b.st[1];
        if (nloc == 0u) { xcd_barrier_complete(bar, b.x, nloc, nx); b.st[0] = nloc; b.st[1] = nx; }
        const unsigned old = xb_add(&bar[XB_XSUB(b.x)], 1u);
        const unsigned gen = old / nloc;
        if (old + 1u == (gen + 1u) * nloc) {
            __builtin_amdgcn_fence(__ATOMIC_RELEASE, "agent");
            asm volatile("s_waitcnt vmcnt(0)" ::: "memory");
            const unsigned og = xb_add(&bar[XB_TOP], 1u);
            const unsigned tg = og / nx;
            if (og + 1u == (tg + 1u) * nx) xb_add(&bar[XB_TOPGEN], 1u);
            else XB_SPIN(xb_ld(&bar[XB_TOPGEN]) == tg, bar);
            __builtin_amdgcn_fence(__ATOMIC_ACQUIRE, "agent");
            xb_add(&bar[XB_XGEN(b.x)], 1u);
            asm volatile("s_waitcnt vmcnt(0)" ::: "memory");
        } else {
            XB_SPIN(xb_ld(&bar[XB_XGEN(b.x)]) == gen, bar);
            __builtin_amdgcn_fence(__ATOMIC_ACQUIRE, "agent");
            asm volatile("s_waitcnt vmcnt(0)" ::: "memory");
        }
    }
    __syncthreads();
}

struct Params { const float* in[16]; float* out; unsigned char* ws; unsigned long long use_cg; };

__global__ void __launch_bounds__(512, 2) fwd_megakernel(Params p) {
    extern __shared__ __attribute__((aligned(16))) unsigned char lds_raw[];
    cg::grid_group grid = cg::this_grid();
    LAS unsigned char* lds = (LAS unsigned char*)lds_raw;
    const int G = gridDim.x, bx = blockIdx.x, NGW = G * 8;
    { volatile LAS unsigned* misc = (volatile LAS unsigned*)(lds + 131072); if (threadIdx.x < 64) misc[threadIdx.x] = 0u; }
    __syncthreads();
    XcdBarrier bar = xcd_barrier_post((unsigned*)(p.ws + WS_CTL), (volatile LAS unsigned*)(lds + 131072));
#define GRID_BAR() do { if (p.use_cg) grid.sync(); else xcd_barrier(bar); } while (0)
#define FRESH_IDS() int tid = threadIdx.x; asm volatile("" : "+v"(tid)); const int lane = tid & 63, wid = __builtin_amdgcn_readfirstlane(tid >> 6); const int gw = bx * 8 + wid; (void)gw; (void)lane
    unsigned char* ws = p.ws;
    const float* x = p.in[0]; const float* pre_g = p.in[1]; const float* w_in = p.in[2]; const float* rpb = p.in[3];
    const float* sgu_ln_g = p.in[4]; const float* sgu_ln_b = p.in[5]; const float* sgu_w = p.in[6]; const float* sgu_b = p.in[7];
    const float* conv_w = p.in[8]; const float* conv_b = p.in[9]; const float* conv_ln_g = p.in[10]; const float* conv_ln_b = p.in[11];
    const float* conv_pw_w = p.in[12]; const float* conv_pw_b = p.in[13]; const float* w_out = p.in[14]; const float* post_g = p.in[15];
    bf16_t* WinT = (bf16_t*)(ws + WS_WIN); bf16_t* WoutT = (bf16_t*)(ws + WS_WOUT); bf16_t* PwT = (bf16_t*)(ws + WS_PW); bf16_t* SgW = (bf16_t*)(ws + WS_SGW);
    float* SSQ = (float*)(ws + WS_SSQ); bf16_t* H = (bf16_t*)(ws + WS_H); bf16_t* Z = (bf16_t*)(ws + WS_Z); bf16_t* VT = (bf16_t*)(ws + WS_VT);
    bf16_t* YC = (bf16_t*)(ws + WS_YC); float* Y = (float*)(ws + WS_Y); float* X1 = (float*)(ws + WS_X1);

    {
        FRESH_IDS();
        LAS float* scr = (LAS float*)(lds + wid * 16384);
        constexpr int I_IN = (DM / 64) * (DIN / 32), I_PW = (512 / 64) * (512 / 32);
        constexpr int NITEMS = I_IN + 2 * I_PW;
        for (int it = gw; it < NITEMS; it += NGW) {
            int r = it;
            if (r < I_IN) { p0_transpose_item(w_in, DM, DIN, WinT, scr, r, lane); continue; } r -= I_IN;
            { const int l = r / I_PW; p0_transpose_item(conv_pw_w + (size_t)l * 512 * 512, 512, 512, PwT + (size_t)l * 512 * 512, scr, r % I_PW, lane); }
        }
        for (int i = gw * 64 + lane; i < 2 * 4 * 128 * 128 / 2; i += NGW * 64) { const f32x2 v = *(const f32x2*)(sgu_w + 2 * (size_t)i); ((unsigned*)SgW)[i] = cvt_pk_bf16(v[0], v[1]); }
        for (int m = gw; m < MTOK; m += NGW) row_update<false, false, true>(x + (size_t)m * DM, nullptr, nullptr, nullptr, pre_g, nullptr, H + (size_t)m * DM, lane);
    }
    GRID_BAR();

#pragma unroll 1
    for (int l = 0; l < DEPTH; ++l) {
        const float* xin = (l == 0) ? x : X1;
        float* xout = (l == DEPTH - 1) ? p.out : X1;
        {
            const bf16_t* W = WinT + (size_t)l * DIN * DM;
            { pg8::Gemm g{H, W, MTOK, DIN - 1024, DM}; pg8::StaticOrder S; S.init(MTOK, DIN - 1024, G, bx, 8, 4); pg8::EpiBf16 E{Z, DIN};
              pg8::gemm_phase<pg8::EpiBf16, pg8::StaticOrder>(lds, g, S, E); }
            const int cvt_first = (G > 128) ? 128 : 0;
            if (l == 0 && bx >= cvt_first) {
                FRESH_IDS();
                LAS float* scr = (LAS float*)(lds + wid * 16384);
                constexpr int I_IN = (DM / 64) * (DIN / 32), I_OUT = (DMIX / 64) * (DM / 32);
                const int gw2 = (bx - cvt_first) * 8 + wid, NGW2 = (G - cvt_first) * 8;
                for (int it = gw2; it < I_IN + 2 * I_OUT; it += NGW2) {
                    int r = it;
                    if (r < I_OUT) { p0_transpose_item(w_out, DMIX, DM, WoutT, scr, r, lane); continue; } r -= I_OUT;
                    if (r < I_IN) { p0_transpose_item(w_in + (size_t)DM * DIN, DM, DIN, WinT + (size_t)DIN * DM, scr, r, lane); continue; } r -= I_IN;
                    p0_transpose_item(w_out + (size_t)DMIX * DM, DMIX, DM, WoutT + (size_t)DM * DMIX, scr, r, lane);
                }
            }
            { pg8::Gemm g{W + (size_t)OFF_V * DM, H, 1024, MTOK, DM}; pg8::StaticOrder S; S.init(1024, MTOK, G, bx, 1 << 30, 0); pg8::EpiBf16 E{VT, MTOK};
              pg8::gemm_phase<pg8::EpiBf16, pg8::StaticOrder>(lds, g, S, E); }
        }
        GRID_BAR();
        {
            { FRESH_IDS();
            for (int it = bx; it < 256; it += G)
                conv_item(lds, Z, PwT + (size_t)l * 512 * 512, conv_w + (size_t)l * 31 * 512, conv_b + l * 512, conv_ln_g + l * 512, conv_ln_b + l * 512, conv_pw_b + l * 512, YC, it, tid, wid, lane); }
            { FRESH_IDS();
            for (int it = bx; it < 256; it += G)
                sgu_item(lds, Z, SgW + (size_t)l * 4 * 128 * 128, sgu_ln_g + l * 512, sgu_ln_b + l * 512, sgu_b + l * 512, YC, it, wid, lane); }
            { FRESH_IDS();
            LAS float* rpbl = (LAS float*)lds;
            { float rv[8];
#pragma unroll
              for (int k = 0; k < 8; ++k) { const int i = tid + 512 * k; rv[k] = (i < 8 * 15 * 31) ? rpb[(size_t)l * 8 * 15 * 31 + i] : 0.f; }
#pragma unroll
              for (int k = 0; k < 8; ++k) { const int i = tid + 512 * k; if (i < 8 * 15 * 31) rpbl[i] = rv[k]; } }
            __syncthreads();
            for (int wi = gw; wi < NB * 8 * 32 * 4; wi += NGW) {
                const int j = wi & 3, r = (wi >> 2) & 31, h = (wi >> 7) & 7, b = wi >> 10;
                attn_wave_item(Z, VT, rpbl, YC, b, h, r, j, lane);
            } }
        }
        GRID_BAR();
        {
            pg8::Gemm g{YC, WoutT + (size_t)l * DM * DMIX, MTOK, DM, DMIX}; pg8::StaticOrder S; S.init(MTOK, DM, G, bx, 1 << 30, 0); pg8::EpiF32Ssq E{Y, DM, SSQ};
            pg8::gemm_phase<pg8::EpiF32Ssq, pg8::StaticOrder>(lds, g, S, E);
        }
        GRID_BAR();
        if (l == 0) {
            FRESH_IDS();
            for (int m = gw; m < MTOK; m += NGW)
                row_update<true, true, true>(xin + (size_t)m * DM, Y + (size_t)m * DM, SSQ + (size_t)m * 32, post_g + l * DM, pre_g + (l + 1) * DM, xout + (size_t)m * DM, H + (size_t)m * DM, lane);
            GRID_BAR();
        } else {
            FRESH_IDS();
            for (int m = gw; m < MTOK; m += NGW)
                row_update<true, true, false>(xin + (size_t)m * DM, Y + (size_t)m * DM, SSQ + (size_t)m * 32, post_g + l * DM, nullptr, xout + (size_t)m * DM, nullptr, lane);
        }
    }
}

extern "C" void kernel_launch(void* const* d_in, const int* in_sizes, int n_in, void* d_out, int out_size, void* d_ws, size_t ws_size, hipStream_t stream) {
    static int grid_blocks = 0;
    if (grid_blocks == 0) {
        if (n_in != 16 || ws_size < WS_END) { fprintf(stderr, "kernel_launch: unexpected n_in %d / ws_size %zu\n", n_in, ws_size); grid_blocks = -1; return; }
        int dev = 0, cus = 0, per_cu = 0;
        hipGetDevice(&dev);
        hipDeviceGetAttribute(&cus, hipDeviceAttributeMultiprocessorCount, dev);
        if (hipFuncSetAttribute((const void*)fwd_megakernel, hipFuncAttributeMaxDynamicSharedMemorySize, LDS_BYTES) != hipSuccess) fprintf(stderr, "kernel_launch: hipFuncSetAttribute failed\n");
        if (hipOccupancyMaxActiveBlocksPerMultiprocessor(&per_cu, (const void*)fwd_megakernel, 512, LDS_BYTES) != hipSuccess || per_cu < 1) { fprintf(stderr, "kernel_launch: occupancy query says %d\n", per_cu); per_cu = 1; }
        (void)hipGetLastError();
        grid_blocks = cus * 1;
    }
    if (grid_blocks < 0) return;
    if (hipMemsetAsync((char*)d_ws + WS_CTL, 0, CTL_BYTES, stream) != hipSuccess) { fprintf(stderr, "kernel_launch: memset failed\n"); return; }
    Params p{};
    for (int i = 0; i < 16; ++i) p.in[i] = (const float*)d_in[i];
    p.out = (float*)d_out; p.ws = (unsigned char*)d_ws;
    void* args[] = {&p};
    hipError_t e = hipLaunchCooperativeKernel((const void*)fwd_megakernel, dim3(grid_blocks), dim3(512), args, LDS_BYTES, stream);
    if (e != hipSuccess) fprintf(stderr, "cooperative launch failed: %s (grid %d)\n", hipGetErrorString(e), grid_blocks);
}
```

```cpp
#include <hip/hip_runtime.h>
#include <hip/hip_cooperative_groups.h>
#include <cstdio>
namespace cg = cooperative_groups;

#define LAS __attribute__((address_space(3)))
typedef unsigned short bf16_t;
typedef short bf16x8 __attribute__((ext_vector_type(8)));
typedef float f32x4 __attribute__((ext_vector_type(4)));
typedef float f32x2 __attribute__((ext_vector_type(2)));
typedef unsigned u32x4 __attribute__((ext_vector_type(4)));
typedef unsigned u32x2 __attribute__((ext_vector_type(2)));

constexpr int DM = 2048, NB = 4, SEQ = 2048, MTOK = NB * SEQ, DEPTH = 2;
constexpr int DIN = 7168, DMIX = 2048;
constexpr int OFF_Q = 0, OFF_K = 1024, OFF_V = 2048, OFF_GA = 3072, OFF_UB = 4096, OFF_VB = 4608, OFF_GB = 5120, OFF_AC = 5632, OFF_BC = 6144, OFF_GC = 6656;
constexpr float EPS = 1e-6f;

constexpr size_t MiB = 1u << 20;
constexpr size_t WS_WIN = 0;
constexpr size_t WS_WOUT = 56 * MiB;
constexpr size_t WS_PW = 72 * MiB;
constexpr size_t WS_SGW = 73 * MiB;
constexpr size_t WS_SSQ = 74 * MiB;
constexpr size_t WS_CTL = 75 * MiB;
constexpr size_t CTL_BYTES = 16384;
constexpr size_t WS_H = 76 * MiB;
constexpr size_t WS_Z = 108 * MiB;
constexpr size_t WS_VT = 220 * MiB;
constexpr size_t WS_YC = 236 * MiB;
constexpr size_t WS_Y = 268 * MiB;
constexpr size_t WS_X1 = 332 * MiB;
constexpr size_t WS_END = 396 * MiB;

constexpr int LDS_BYTES = 147456;

__device__ __forceinline__ unsigned cvt_pk_bf16(float lo, float hi) { unsigned r; asm volatile("v_cvt_pk_bf16_f32 %0, %1, %2" : "=v"(r) : "v"(lo), "v"(hi)); return r; }
__device__ __forceinline__ float bf_lo(unsigned w) { return __uint_as_float(w << 16); }
__device__ __forceinline__ float bf_hi(unsigned w) { return __uint_as_float(w & 0xffff0000u); }
__device__ __forceinline__ float wave_sum(float v) {
#pragma unroll
    for (int o = 1; o < 64; o <<= 1) v += __shfl_xor(v, o);
    return v;
}
__device__ __forceinline__ float gelu_f(float v) {
    const float av = fabsf(v), t = __builtin_amdgcn_rcpf(av * 0.2316418882f + 1.0f);
    float q = t * 0.5307027145f + (-0.7265760135f); q = q * t + 0.7107068705f; q = q * t + (-0.142248368f); q = q * t + 0.127414796f; q = q * t;
    const float e = __builtin_amdgcn_exp2f((v * v) * (-0.72134752044f));
    const float m = v * (q * e);
    return v < 0.f ? m : v - m;
}
__device__ __forceinline__ float sigmoid_f(float v) { return __builtin_amdgcn_rcpf(1.0f + __expf(-v)); }
__device__ __forceinline__ float silu_f(float v) { return v * __builtin_amdgcn_rcpf(1.0f + __expf(-v)); }
#define LDS_WAIT() asm volatile("s_waitcnt lgkmcnt(0)" ::: "memory")

namespace pg8 {
constexpr int BM = 256, BK = 64, HALF = 128, HTB = HALF * BK * 2, STAGE_BYTES = 8 * HTB, NXCD = 8, WGM = 8;
__device__ __forceinline__ int lds_byte(int r, int c) { const int st = (r >> 4) * 2 + (c >> 5), rr = r & 15, cc = c & 31, ob = rr * 64 + cc * 2; return st * 1024 + (ob ^ (((ob >> 9) & 1) << 5)); }
__device__ __forceinline__ void stage_rc(int b, int& R, int& C) { const int st = b / 1024, sb = b % 1024, swz = sb ^ (((sb >> 9) & 1) << 5); R = (st >> 1) * 16 + swz / 64; C = (st & 1) * 32 + (swz % 64) / 2; }
__device__ __forceinline__ int perm32(int rho) { const int n = rho >> 4, i = rho & 15; return 8 * (i >> 2) + 4 * n + (i & 3); }

struct Unit { int pm, pn; };
struct Gemm { const bf16_t* A; const bf16_t* Bt; int M, N, K; };

struct StaticOrder {
    int nM, nN, nwg, G, c, skip_from, skip;
    __device__ void init(int M, int N, int G_, int c_, int skip_from_, int skip_) { nM = M / BM; nN = N / BM; nwg = nM * nN; G = G_; c = c_; skip_from = skip_from_; skip = skip_; }
    __device__ bool next(int i, Unit& u) const {
        const long L = (long)i * G + c; if (L >= nwg) return false;
        int wgid = (int)L; { const int q = nwg / NXCD, r = nwg % NXCD, xcd = wgid % NXCD, off = wgid / NXCD; wgid = (xcd < r ? xcd * (q + 1) : r * (q + 1) + (xcd - r) * q) + off; }
        const int nig = WGM * nN, gid = wgid / nig, fm = gid * WGM, gsz = (nM - fm) < WGM ? (nM - fm) : WGM;
        u.pm = fm + ((wgid % nig) % gsz); u.pn = (wgid % nig) / gsz;
        if (u.pn >= skip_from) u.pn += skip;
        return true;
    }
    __device__ __forceinline__ void a_ready(const Unit&) const {}
    __device__ __forceinline__ void done(const Unit&) const {}
};

struct EpiBf16 {
    static constexpr bool PERM = true;
    bf16_t* O; int ldc;
    __device__ __forceinline__ void operator()(const f32x4 (&acc)[2][2][4][2], const Unit& u, int wr, int wc, int fr, int fq) const {
        const int row0 = u.pm * BM + wr * 64 + fr; const int col0 = u.pn * BM + wc * 32 + 8 * fq;
#pragma unroll
        for (int ai = 0; ai < 2; ++ai)
#pragma unroll
            for (int m = 0; m < 4; ++m) { bf16_t* rowp = O + (size_t)(row0 + ai * HALF + m * 16) * ldc + col0;
#pragma unroll
                for (int bj = 0; bj < 2; ++bj) { const f32x4 v0 = acc[ai][bj][m][0], v1 = acc[ai][bj][m][1];
                    u32x4 w; w.x = cvt_pk_bf16(v0[0], v0[1]); w.y = cvt_pk_bf16(v0[2], v0[3]); w.z = cvt_pk_bf16(v1[0], v1[1]); w.w = cvt_pk_bf16(v1[2], v1[3]);
                    *(u32x4*)(rowp + bj * HALF) = w; } }
    }
};
struct EpiF32Ssq {
    static constexpr bool PERM = false;
    float* C; int ldc; float* ssq;
    __device__ __forceinline__ void operator()(const f32x4 (&acc)[2][2][4][2], const Unit& u, int wr, int wc, int fr, int fq) const {
        const int row0 = u.pm * BM + wr * 64 + fr, col0 = u.pn * BM + wc * 32 + 4 * fq;
#pragma unroll
        for (int ai = 0; ai < 2; ++ai)
#pragma unroll
            for (int m = 0; m < 4; ++m) { const int row = row0 + ai * HALF + m * 16; float* rowp = C + (size_t)row * ldc + col0; float s = 0.f;
#pragma unroll
                for (int bj = 0; bj < 2; ++bj)
#pragma unroll
                    for (int n = 0; n < 2; ++n) { const f32x4 v = acc[ai][bj][m][n]; *(f32x4*)(rowp + bj * HALF + n * 16) = v; s += (v[0] * v[0] + v[1] * v[1]) + (v[2] * v[2] + v[3] * v[3]); }
                s += __shfl_xor(s, 16); s += __shfl_xor(s, 32);
                if (fq == 0) ssq[(size_t)row * 32 + u.pn * 4 + wc] = s; }
    }
};

template <class Epi, class Sched>
__device__ __forceinline__ void gemm_phase(LAS unsigned char* lds, const Gemm g, const Sched& S, const Epi& E) {
    int tid = threadIdx.x; asm volatile("" : "+v"(tid));
    const int wid = __builtin_amdgcn_readfirstlane(tid >> 6), lane = tid & 63, wr = wid >> 2, wc = wid & 3, fr = lane & 15, fq = lane >> 4;
    const int K = g.K, nt = K / BK;
    unsigned voffA[2], voffB[2];
#pragma unroll
    for (int i = 0; i < 2; ++i) { int R, C; stage_rc(tid * 16 + i * 8192, R, C); const int Rb = Epi::PERM ? ((R & ~31) + perm32(R & 31)) : R;
        voffA[i] = (unsigned)(R * K + C) * 2u; voffB[i] = (unsigned)(Rb * K + C) * 2u; }
    const size_t kstep = (size_t)(BK * 2);
    const size_t hstep = (size_t)HALF * K * 2;
    const size_t tstep = 2 * hstep;
    const unsigned ldsw = (unsigned)wid * 1024u;
    const int aoff = lds_byte(wr * 64 + fr, fq * 8), boff = lds_byte(wc * 32 + fr, fq * 8);
#define PG8_SA(b, h) (((b) * 2 + (h)) * HTB)
#define PG8_SB(b, h) ((4 + (b) * 2 + (h)) * HTB)
#define PG8_STAGE(bufoff, gbase, voff) do { _Pragma("unroll") for (int _i = 0; _i < 2; ++_i) \
        __builtin_amdgcn_global_load_lds((const unsigned*)((const char*)(gbase) + (voff)[_i]), (LAS unsigned*)(lds + (bufoff) + ldsw + _i * 8192), 16, 0, 0); } while (0)
#define PG8_LDA(dst, b, h) do { _Pragma("unroll") for (int m = 0; m < 4; ++m) _Pragma("unroll") for (int k = 0; k < 2; ++k) dst[m][k] = *(const LAS bf16x8*)(lds + PG8_SA(b, h) + aoff + m * 2048 + k * 1024); } while (0)
#define PG8_LDB(dst, b, h) do { _Pragma("unroll") for (int n = 0; n < 2; ++n) _Pragma("unroll") for (int k = 0; k < 2; ++k) dst[n][k] = *(const LAS bf16x8*)(lds + PG8_SB(b, h) + boff + n * 2048 + k * 1024); } while (0)
#define PG8_MMA(ai, bj, At, Bt) do { __builtin_amdgcn_s_setprio(1); _Pragma("unroll") for (int m = 0; m < 4; ++m) _Pragma("unroll") for (int n = 0; n < 2; ++n) _Pragma("unroll") for (int k = 0; k < 2; ++k) \
        acc[ai][bj][m][n] = __builtin_amdgcn_mfma_f32_16x16x32_bf16(Bt[n][k], At[m][k], acc[ai][bj][m][n], 0, 0, 0); __builtin_amdgcn_s_setprio(0); } while (0)
#define PG8_WAIT_V(n) asm volatile("s_waitcnt vmcnt(" #n ")" ::: "memory")
#define PG8_WAIT_L(n) asm volatile("s_waitcnt lgkmcnt(" #n ")" ::: "memory")
#define PG8_BAR __builtin_amdgcn_s_barrier()
#define PG8_SCHED __builtin_amdgcn_sched_barrier(0)
    Unit cur, nxt; int ui = 0;
    if (!S.next(0, cur)) return;
    f32x4 acc[2][2][4][2];
#pragma unroll
    for (int a = 0; a < 2; ++a)
#pragma unroll
        for (int b = 0; b < 2; ++b)
#pragma unroll
            for (int m = 0; m < 4; ++m)
#pragma unroll
                for (int n = 0; n < 2; ++n) acc[a][b][m][n] = (f32x4){0.f, 0.f, 0.f, 0.f};
    bf16x8 At[4][2], B0[2][2], B1[2][2];
    const char* cA = (const char*)g.A + (size_t)cur.pm * tstep; const char* cB = (const char*)g.Bt + (size_t)cur.pn * tstep;
    S.a_ready(cur);
    PG8_STAGE(PG8_SB(0, 0), cB, voffB); PG8_STAGE(PG8_SA(0, 0), cA, voffA); PG8_STAGE(PG8_SB(0, 1), cB + hstep, voffB); PG8_STAGE(PG8_SA(0, 1), cA + hstep, voffA);
    if (wr == 1) PG8_BAR;
    PG8_WAIT_V(4); PG8_BAR;
    PG8_STAGE(PG8_SB(1, 0), cB + kstep, voffB); PG8_STAGE(PG8_SA(1, 0), cA + kstep, voffA); PG8_STAGE(PG8_SB(1, 1), cB + hstep + kstep, voffB);
    PG8_WAIT_V(6); PG8_BAR;
    for (;;) {
        const bool has_next = S.next(ui + 1, nxt);
        const char* nA = has_next ? (const char*)g.A + (size_t)nxt.pm * tstep : cA; const char* nB = has_next ? (const char*)g.Bt + (size_t)nxt.pn * tstep : cB;
        for (int t = 0; t < nt; t += 2) {
            const bool last = (t == nt - 2);
            const char* a1 = cA + (size_t)(t + 1) * kstep;
            const char* a2 = last ? nA : cA + (size_t)(t + 2) * kstep; const char* b2 = last ? nB : cB + (size_t)(t + 2) * kstep;
            const char* a3 = a2 + kstep; const char* b3 = b2 + kstep;
            if (last && has_next) S.a_ready(nxt);
            PG8_LDB(B0, 0, 0); PG8_SCHED; PG8_LDA(At, 0, 0); PG8_STAGE(PG8_SA(1, 1), a1 + hstep, voffA);
            PG8_WAIT_L(8); PG8_BAR; PG8_WAIT_L(0); PG8_MMA(0, 0, At, B0); PG8_BAR; PG8_SCHED;
            PG8_LDB(B1, 0, 1); PG8_STAGE(PG8_SB(0, 0), b2, voffB);
            PG8_BAR; PG8_WAIT_L(0); PG8_MMA(0, 1, At, B1); PG8_BAR;
            PG8_LDA(At, 0, 1); PG8_STAGE(PG8_SA(0, 0), a2, voffA);
            PG8_BAR; PG8_WAIT_L(0); PG8_MMA(1, 0, At, B0); PG8_BAR; PG8_SCHED;
            PG8_STAGE(PG8_SB(0, 1), b2 + hstep, voffB);
            PG8_WAIT_V(6); PG8_BAR; PG8_MMA(1, 1, At, B1); PG8_BAR;
            PG8_LDB(B0, 1, 0); PG8_SCHED; PG8_LDA(At, 1, 0); PG8_STAGE(PG8_SA(0, 1), a2 + hstep, voffA);
            PG8_WAIT_L(8); PG8_BAR; PG8_WAIT_L(0); PG8_MMA(0, 0, At, B0); PG8_BAR; PG8_SCHED;
            PG8_LDB(B1, 1, 1); PG8_STAGE(PG8_SB(1, 0), b3, voffB);
            PG8_BAR; PG8_WAIT_L(0); PG8_MMA(0, 1, At, B1); PG8_BAR;
            PG8_LDA(At, 1, 1); PG8_STAGE(PG8_SA(1, 0), a3, voffA);
            PG8_BAR; PG8_WAIT_L(0); PG8_MMA(1, 0, At, B0); PG8_BAR; PG8_SCHED;
            PG8_STAGE(PG8_SB(1, 1), b3 + hstep, voffB);
            PG8_WAIT_V(6); PG8_BAR; PG8_MMA(1, 1, At, B1); PG8_BAR;
        }
        E(acc, cur, wr, wc, fr, fq); S.done(cur);
        if (!has_next) break;
#pragma unroll
        for (int a = 0; a < 2; ++a)
#pragma unroll
            for (int b = 0; b < 2; ++b)
#pragma unroll
                for (int m = 0; m < 4; ++m)
#pragma unroll
                    for (int n = 0; n < 2; ++n) acc[a][b][m][n] = (f32x4){0.f, 0.f, 0.f, 0.f};
        cur = nxt; cA = nA; cB = nB; ++ui;
    }
    PG8_WAIT_V(0);
    if (wr == 0) PG8_BAR;
    PG8_BAR;
#undef PG8_SA
#undef PG8_SB
#undef PG8_STAGE
#undef PG8_LDA
#undef PG8_LDB
#undef PG8_MMA
#undef PG8_WAIT_V
#undef PG8_WAIT_L
#undef PG8_BAR
#undef PG8_SCHED
}
}

__device__ __forceinline__ void p0_transpose_item(const float* W, int K, int N, bf16_t* WT, LAS float* scr, int item, int lane) {
    const int nblk = N / 32, kb = item / nblk, nb = item % nblk, k0 = 64 * kb, n0 = 32 * nb;
    float tv[32];
#pragma unroll
    for (int i = 0; i < 32; ++i) { const int kk = 2 * i + (lane >> 5); tv[i] = W[(size_t)(k0 + kk) * N + n0 + (lane & 31)]; }
#pragma unroll
    for (int i = 0; i < 32; ++i) { const int kk = 2 * i + (lane >> 5); scr[kk * 33 + (lane & 31)] = tv[i]; }
    LDS_WAIT(); asm volatile("" ::: "memory");
    const int c = lane & 7;
#pragma unroll
    for (int j = 0; j < 4; ++j) { const int n = (lane >> 3) + 8 * j; const LAS float* s = scr + (8 * c) * 33 + n;
        u32x4 o; o.x = cvt_pk_bf16(s[0 * 33], s[1 * 33]); o.y = cvt_pk_bf16(s[2 * 33], s[3 * 33]); o.z = cvt_pk_bf16(s[4 * 33], s[5 * 33]); o.w = cvt_pk_bf16(s[6 * 33], s[7 * 33]);
        *(u32x4*)(WT + (size_t)(n0 + n) * K + k0 + 8 * c) = o; }
    LDS_WAIT(); asm volatile("" ::: "memory");
}

template <bool HAS_Y, bool WRITE_X, bool WRITE_H>
__device__ __forceinline__ void row_update(const float* xrow, const float* yrow, const float* ssq_row, const float* gpost, const float* gpre, float* xout, bf16_t* hout, int lane) {
    f32x4 v[8];
    const f32x4* xr = (const f32x4*)xrow + lane;
#pragma unroll
    for (int j = 0; j < 8; ++j) v[j] = xr[64 * j];
    if (HAS_Y) {
        float s = ssq_row[lane & 31];
#pragma unroll
        for (int o = 1; o < 32; o <<= 1) s += __shfl_xor(s, o);
        const float rstd = 1.0f / sqrtf(s * (1.0f / DM) + EPS);
        const f32x4* yr = (const f32x4*)yrow + lane; const f32x4* gp = (const f32x4*)gpost + lane;
#pragma unroll
        for (int j = 0; j < 8; ++j) { const f32x4 y = yr[64 * j], g = gp[64 * j]; v[j] = v[j] + (y * rstd) * g; }
    }
    if (WRITE_X) { f32x4* xo = (f32x4*)xout + lane;
#pragma unroll
        for (int j = 0; j < 8; ++j) xo[64 * j] = v[j]; }
    if (WRITE_H) {
        float s2 = 0.f;
#pragma unroll
        for (int j = 0; j < 8; ++j) s2 += (v[j][0] * v[j][0] + v[j][1] * v[j][1]) + (v[j][2] * v[j][2] + v[j][3] * v[j][3]);
        const float rstd2 = 1.0f / sqrtf(wave_sum(s2) * (1.0f / DM) + EPS);
        const f32x4* gq = (const f32x4*)gpre + lane; u32x2* ho = (u32x2*)hout + lane;
#pragma unroll
        for (int j = 0; j < 8; ++j) { const f32x4 g = gq[64 * j]; u32x2 w; w.x = cvt_pk_bf16(v[j][0] * rstd2 * g[0], v[j][1] * rstd2 * g[1]); w.y = cvt_pk_bf16(v[j][2] * rstd2 * g[2], v[j][3] * rstd2 * g[3]); ho[64 * j] = w; }
    }
}

#define SCHED_BAR() __builtin_amdgcn_sched_barrier(0)
__device__ __forceinline__ int swz16(int rr, int pc4) { const int ob = rr * 64 + pc4 * 16; return ob ^ (((ob >> 9) & 1) << 5); }
__device__ __forceinline__ void attn_block_item(LAS unsigned char* lds, const LAS float* rpbl, const bf16_t* Z, const bf16_t* VT, bf16_t* YC, int b, int h, int rb, int j, int tid, int wid, int lane) {
    asm volatile("" : "+v"(tid)); lane = tid & 63;
    const int fr = lane & 15, fq = lane >> 4;
    const int r0 = 8 * rb;
    const int ub0 = min(max(r0 - 4, 0), 24), nb = min(max(r0 + 3, 0), 24) + 8 - ub0;
    const int kc0 = (j == 0) ? 0 : (j == 1) ? 8 : (j == 2) ? 24 : 32;
    const int r = r0 + wid, rs = min(max(r - 4, 0), 24), sl0 = rs - ub0;
    const int w = j * 16 + fr;
    const int tokq = b * SEQ + r * 64 + w;
    const int cs = min(max(w - 8, 0), 48);
    u32x4 stg[15];
    {
        const int key = tid >> 4, pc = tid & 15;
        const bf16_t* kp = Z + (size_t)(b * SEQ + ub0 * 64 + kc0 + key) * DIN + OFF_K + h * 128 + 8 * pc;
#pragma unroll
        for (int sl = 0; sl < 15; ++sl) if (sl < nb) stg[sl] = *(const u32x4*)(kp + (size_t)sl * 64 * DIN);
    }
    bf16x8 qf[4];
    { const bf16_t* qp = Z + (size_t)tokq * DIN + OFF_Q + h * 128 + 8 * fq;
#pragma unroll
      for (int s = 0; s < 4; ++s) qf[s] = *(const bf16x8*)(qp + 32 * s); }
    SCHED_BAR();
    {
        const int key = tid >> 4, pc = tid & 15;
        const int woff = ((key >> 4) * 4 + (pc >> 2)) * 1024 + swz16(key & 15, pc & 3);
#pragma unroll
        for (int sl = 0; sl < 15; ++sl) if (sl < nb) *(LAS u32x4*)(lds + sl * 8192 + woff) = stg[sl];
    }
    __syncthreads();
    {
        const int d = tid >> 2, c = tid & 3;
        const bf16_t* vp = VT + (size_t)(h * 128 + d) * MTOK + b * SEQ + ub0 * 64 + kc0 + 8 * c;
#pragma unroll
        for (int sl = 0; sl < 15; ++sl) if (sl < nb) stg[sl] = *(const u32x4*)(vp + sl * 64);
    }
    const bf16_t* gp = Z + (size_t)tokq * DIN + OFF_GA + h * 128 + 4 * fq;
    u32x2 gwv[8];
#pragma unroll
    for (int dt = 0; dt < 8; ++dt) gwv[dt] = *(const u32x2*)(gp + 16 * dt);
    SCHED_BAR();
    f32x4 sacc[8][2];
    const int rdo = swz16(fr, fq);
#pragma unroll
    for (int i = 0; i < 8; ++i)
#pragma unroll
        for (int hf = 0; hf < 2; ++hf) {
            f32x4 a = (f32x4){0.f, 0.f, 0.f, 0.f};
#pragma unroll
            for (int s = 0; s < 4; ++s) a = __builtin_amdgcn_mfma_f32_16x16x32_bf16(*(const LAS bf16x8*)(lds + (sl0 + i) * 8192 + (hf * 4 + s) * 1024 + rdo), qf[s], a, 0, 0, 0);
            sacc[i][hf] = a;
        }
    const float scale = 0.08838834764831845f;
    const LAS float* rp = rpbl + h * (15 * 31);
    float mx = -1e30f;
#pragma unroll
    for (int i = 0; i < 8; ++i) {
        const int dr = rs + i - r + 7;
#pragma unroll
        for (int hf = 0; hf < 2; ++hf)
#pragma unroll
            for (int rg = 0; rg < 4; ++rg) {
                const int kc = kc0 + 16 * hf + 4 * fq + rg;
                const bool valid = (kc >= cs) && (kc < cs + 16);
                const int dc = min(max(kc - w + 15, 0), 30);
                const float sv = sacc[i][hf][rg] * scale + rp[dr * 31 + dc];
                sacc[i][hf][rg] = valid ? sv : -1e30f;
                mx = fmaxf(mx, sacc[i][hf][rg]);
            }
    }
    mx = fmaxf(mx, __shfl_xor(mx, 16)); mx = fmaxf(mx, __shfl_xor(mx, 32));
    float sum = 0.f;
    bf16x8 pf[8];
#pragma unroll
    for (int i = 0; i < 8; ++i) {
        float pv[8];
#pragma unroll
        for (int hf = 0; hf < 2; ++hf)
#pragma unroll
            for (int rg = 0; rg < 4; ++rg) { const float sv = sacc[i][hf][rg]; const float pe = (sv > -1e29f) ? __expf(sv - mx) : 0.f; pv[hf * 4 + rg] = pe; sum += pe; }
        u32x4 pk; pk.x = cvt_pk_bf16(pv[0], pv[1]); pk.y = cvt_pk_bf16(pv[2], pv[3]); pk.z = cvt_pk_bf16(pv[4], pv[5]); pk.w = cvt_pk_bf16(pv[6], pv[7]);
        pf[i] = __builtin_bit_cast(bf16x8, pk);
    }
    sum += __shfl_xor(sum, 16); sum += __shfl_xor(sum, 32);
    const float inv = __builtin_amdgcn_rcpf(sum);
    __syncthreads();
    {
        const int d = tid >> 2, c = tid & 3;
        const int wo0 = (d >> 4) * 1024 + swz16(d & 15, 2 * (c & 1)) + 8 * (c >> 1), wo1 = (d >> 4) * 1024 + swz16(d & 15, 2 * (c & 1) + 1) + 8 * (c >> 1);
#pragma unroll
        for (int sl = 0; sl < 15; ++sl) if (sl < nb) { *(LAS u32x2*)(lds + sl * 8192 + wo0) = (u32x2){stg[sl].x, stg[sl].y}; *(LAS u32x2*)(lds + sl * 8192 + wo1) = (u32x2){stg[sl].z, stg[sl].w}; }
    }
    __syncthreads();
    f32x4 oacc[8];
#pragma unroll
    for (int dt = 0; dt < 8; ++dt) oacc[dt] = (f32x4){0.f, 0.f, 0.f, 0.f};
#pragma unroll
    for (int i = 0; i < 8; ++i)
#pragma unroll
        for (int dt = 0; dt < 8; ++dt) oacc[dt] = __builtin_amdgcn_mfma_f32_16x16x32_bf16(*(const LAS bf16x8*)(lds + (sl0 + i) * 8192 + dt * 1024 + rdo), pf[i], oacc[dt], 0, 0, 0);
    bf16_t* op = YC + (size_t)tokq * DMIX + h * 128 + 4 * fq;
#pragma unroll
    for (int dt = 0; dt < 8; ++dt) {
        const u32x2 gw = gwv[dt];
        const float g0 = silu_f(bf_lo(gw.x)), g1 = silu_f(bf_hi(gw.x)), g2 = silu_f(bf_lo(gw.y)), g3 = silu_f(bf_hi(gw.y));
        u32x2 o; o.x = cvt_pk_bf16(oacc[dt][0] * inv * g0, oacc[dt][1] * inv * g1); o.y = cvt_pk_bf16(oacc[dt][2] * inv * g2, oacc[dt][3] * inv * g3);
        *(u32x2*)(op + 16 * dt) = o;
    }
    __syncthreads();
}

constexpr int SGU_ROWB = 272;
__device__ __forceinline__ void sgu_item(LAS unsigned char* lds, const bf16_t* Z, const bf16_t* SGW, const float* ln_g, const float* ln_b, const float* b_s, bf16_t* YC, int item, int wid, int lane) {
    const int g = item & 3, bn = item >> 2;
    const int tk0 = bn * 128;
    const int fr = lane & 15, fq = lane >> 4;
    float lg[8], lb[8];
    { const f32x4* gp4 = (const f32x4*)(ln_g + 8 * lane); const f32x4* bp4 = (const f32x4*)(ln_b + 8 * lane); const f32x4 a0 = gp4[0], a1 = gp4[1], c0 = bp4[0], c1 = bp4[1];
      lg[0] = a0[0]; lg[1] = a0[1]; lg[2] = a0[2]; lg[3] = a0[3]; lg[4] = a1[0]; lg[5] = a1[1]; lg[6] = a1[2]; lg[7] = a1[3];
      lb[0] = c0[0]; lb[1] = c0[1]; lb[2] = c0[2]; lb[3] = c0[3]; lb[4] = c1[0]; lb[5] = c1[1]; lb[6] = c1[2]; lb[7] = c1[3]; }
#pragma unroll 1
    for (int hb = 0; hb < 2; ++hb) {
        u32x4 raw[8];
#pragma unroll
        for (int q = 0; q < 8; ++q) raw[q] = *(const u32x4*)(Z + (size_t)(tk0 + 16 * wid + 8 * hb + q) * DIN + OFF_VB + 8 * lane);
        SCHED_BAR();
        float x[8][8], sm[8];
#pragma unroll
        for (int q = 0; q < 8; ++q) {
            x[q][0] = bf_lo(raw[q].x); x[q][1] = bf_hi(raw[q].x); x[q][2] = bf_lo(raw[q].y); x[q][3] = bf_hi(raw[q].y); x[q][4] = bf_lo(raw[q].z); x[q][5] = bf_hi(raw[q].z); x[q][6] = bf_lo(raw[q].w); x[q][7] = bf_hi(raw[q].w);
            float a = 0.f;
#pragma unroll
            for (int e = 0; e < 8; ++e) { x[q][e] = gelu_f(x[q][e]); a += x[q][e]; }
            sm[q] = a;
        }
#pragma unroll
        for (int o = 1; o < 64; o <<= 1)
#pragma unroll
            for (int q = 0; q < 8; ++q) sm[q] += __shfl_xor(sm[q], o);
        float sq[8];
#pragma unroll
        for (int q = 0; q < 8; ++q) { const float mean = sm[q] * (1.0f / 512.0f); float a = 0.f;
#pragma unroll
            for (int e = 0; e < 8; ++e) { x[q][e] -= mean; a += x[q][e] * x[q][e]; }
            sq[q] = a; }
#pragma unroll
        for (int o = 1; o < 64; o <<= 1)
#pragma unroll
            for (int q = 0; q < 8; ++q) sq[q] += __shfl_xor(sq[q], o);
        if ((lane >> 4) == g) {
            const int cl = 8 * (lane & 15);
#pragma unroll
            for (int q = 0; q < 8; ++q) { const float rstd = 1.0f / sqrtf(sq[q] * (1.0f / 512.0f) + EPS); const int s = 16 * wid + 8 * hb + q;
#pragma unroll
                for (int e = 0; e < 8; ++e) { const float y = x[q][e] * rstd * lg[e] + lb[e]; *(LAS bf16_t*)(lds + (cl + e) * SGU_ROWB + s * 2) = (bf16_t)(cvt_pk_bf16(y, 0.f) & 0xffffu); } }
        }
    }
    const int t = 16 * wid + fr, tok = tk0 + t;
    const bf16_t* zr = Z + (size_t)tok * DIN + g * 128 + 4 * fq;
    u32x2 uwv[8], gwv[8];
#pragma unroll
    for (int ct = 0; ct < 8; ++ct) { uwv[ct] = *(const u32x2*)(zr + OFF_UB + 16 * ct); gwv[ct] = *(const u32x2*)(zr + OFF_GB + 16 * ct); }
    const float bs = b_s[g * 128 + t];
    bf16x8 wf[4];
    { const bf16_t* wp = SGW + (size_t)(g * 128 + 16 * wid + fr) * 128 + 8 * fq;
#pragma unroll
      for (int ks = 0; ks < 4; ++ks) wf[ks] = *(const bf16x8*)(wp + 32 * ks); }
    __syncthreads();
    f32x4 acc[8];
#pragma unroll
    for (int ct = 0; ct < 8; ++ct) {
        f32x4 a = (f32x4){0.f, 0.f, 0.f, 0.f};
#pragma unroll
        for (int ks = 0; ks < 4; ++ks) { const bf16x8 vf = *(const LAS bf16x8*)(lds + (16 * ct + fr) * SGU_ROWB + (32 * ks + 8 * fq) * 2); a = __builtin_amdgcn_mfma_f32_16x16x32_bf16(vf, wf[ks], a, 0, 0, 0); }
        acc[ct] = a;
    }
    bf16_t* op = YC + (size_t)tok * DMIX + 1024 + g * 128 + 4 * fq;
#pragma unroll
    for (int ct = 0; ct < 8; ++ct) {
        const u32x2 uw = uwv[ct], gw = gwv[ct];
        const float u0 = gelu_f(bf_lo(uw.x)), u1 = gelu_f(bf_hi(uw.x)), u2 = gelu_f(bf_lo(uw.y)), u3 = gelu_f(bf_hi(uw.y));
        const float g0 = silu_f(bf_lo(gw.x)), g1 = silu_f(bf_hi(gw.x)), g2 = silu_f(bf_lo(gw.y)), g3 = silu_f(bf_hi(gw.y));
        u32x2 o; o.x = cvt_pk_bf16(u0 * (acc[ct][0] + bs) * g0, u1 * (acc[ct][1] + bs) * g1); o.y = cvt_pk_bf16(u2 * (acc[ct][2] + bs) * g2, u3 * (acc[ct][3] + bs) * g3);
        *(u32x2*)(op + 16 * ct) = o;
    }
    __syncthreads();
}

constexpr int CV_G_OFF = 0, CV_G_ROWS = 62, CV_C_OFF = 63488, CV_A_ROWB = 1040;
__device__ __forceinline__ unsigned glu_pk(unsigned a, unsigned b) { return cvt_pk_bf16(bf_lo(a) * sigmoid_f(bf_lo(b)), bf_hi(a) * sigmoid_f(bf_hi(b))); }
__device__ __forceinline__ void conv_item(LAS unsigned char* lds, const bf16_t* Z, const bf16_t* PWT, const float* cw, const float* cb, const float* ln_g, const float* ln_b, const float* pwb, bf16_t* YC, int item, int tid, int wid, int lane) {
    const int b = item >> 6, t0 = (item & 63) * 32;
#define REOPAQUE() do { asm volatile("" : "+v"(tid)); lane = tid & 63; fr = lane & 15; fq = lane >> 4; } while (0)
    int fr, fq;
    REOPAQUE();
#pragma unroll 1
    for (int ps = 0; ps < 2; ++ps) {
        u32x4 av[4], bv[4]; bool ok[4];
#pragma unroll
        for (int q = 0; q < 4; ++q) {
            const int wk = tid + 512 * (4 * ps + q), tt = wk >> 6, c8 = (wk & 63) * 8, pp = t0 - 15 + tt;
            ok[q] = (tt < CV_G_ROWS) && (pp >= 0) && (pp < SEQ);
            av[q] = (u32x4){0u, 0u, 0u, 0u}; bv[q] = (u32x4){0u, 0u, 0u, 0u};
            if (ok[q]) { const bf16_t* zr = Z + (size_t)(b * SEQ + pp) * DIN + c8; av[q] = *(const u32x4*)(zr + OFF_AC); bv[q] = *(const u32x4*)(zr + OFF_BC); }
        }
        SCHED_BAR();
#pragma unroll
        for (int q = 0; q < 4; ++q) {
            const int wk = tid + 512 * (4 * ps + q), tt = wk >> 6, c8 = (wk & 63) * 8;
            u32x4 o; o.x = glu_pk(av[q].x, bv[q].x); o.y = glu_pk(av[q].y, bv[q].y); o.z = glu_pk(av[q].z, bv[q].z); o.w = glu_pk(av[q].w, bv[q].w);
            if (tt < CV_G_ROWS) *(LAS u32x4*)(lds + CV_G_OFF + tt * 1024 + c8 * 2) = o;
        }
    }
    __syncthreads();
    REOPAQUE();
    {
        const int cp = tid & 255, th = tid >> 8;
        float w0[31], w1[31];
#pragma unroll
        for (int jj = 0; jj < 31; ++jj) { const f32x2 wv = *(const f32x2*)(cw + jj * 512 + 2 * cp); w0[jj] = wv[0]; w1[jj] = wv[1]; }
        const f32x2 bias = *(const f32x2*)(cb + 2 * cp);
        float a0[16], a1[16];
#pragma unroll
        for (int o = 0; o < 16; ++o) { a0[o] = bias[0]; a1[o] = bias[1]; }
#pragma unroll
        for (int tl = 0; tl < 46; ++tl) {
            const unsigned gv = *(const LAS unsigned*)(lds + CV_G_OFF + (16 * th + tl) * 1024 + cp * 4);
            const float h0 = bf_lo(gv), h1 = bf_hi(gv);
#pragma unroll
            for (int o = 0; o < 16; ++o) { const int jj = tl - o; if (jj >= 0 && jj <= 30) { a0[o] += h0 * w0[jj]; a1[o] += h1 * w1[jj]; } }
        }
#pragma unroll
        for (int o = 0; o < 16; ++o) *(LAS f32x2*)(lds + CV_C_OFF + (16 * th + o) * 2048 + cp * 8) = (f32x2){a0[o], a1[o]};
    }
    __syncthreads();
    REOPAQUE();
    const bf16_t* pw = PWT + (size_t)(64 * wid + fr) * 512 + 8 * fq;
    bf16x8 pfb[4][4];
#pragma unroll
    for (int k0 = 0; k0 < 3; ++k0)
#pragma unroll
        for (int nt = 0; nt < 4; ++nt) pfb[k0][nt] = *(const bf16x8*)(pw + (size_t)(16 * nt) * 512 + 32 * k0);
    {
        const f32x4 g0 = *(const f32x4*)(ln_g + 8 * lane), g1 = *(const f32x4*)(ln_g + 8 * lane + 4), b0 = *(const f32x4*)(ln_b + 8 * lane), b1 = *(const f32x4*)(ln_b + 8 * lane + 4);
        f32x4 x0[4], x1[4]; float sm[4], sq[4];
#pragma unroll
        for (int q = 0; q < 4; ++q) { const int t = 4 * wid + q;
            x0[q] = *(const LAS f32x4*)(lds + CV_C_OFF + t * 2048 + lane * 32); x1[q] = *(const LAS f32x4*)(lds + CV_C_OFF + t * 2048 + lane * 32 + 16);
            sm[q] = (x0[q][0] + x0[q][1]) + (x0[q][2] + x0[q][3]) + (x1[q][0] + x1[q][1]) + (x1[q][2] + x1[q][3]); }
#pragma unroll
        for (int o = 1; o < 64; o <<= 1)
#pragma unroll
            for (int q = 0; q < 4; ++q) sm[q] += __shfl_xor(sm[q], o);
#pragma unroll
        for (int q = 0; q < 4; ++q) { const float mean = sm[q] * (1.0f / 512.0f); x0[q] = x0[q] - mean; x1[q] = x1[q] - mean;
            sq[q] = (x0[q][0] * x0[q][0] + x0[q][1] * x0[q][1]) + (x0[q][2] * x0[q][2] + x0[q][3] * x0[q][3]) + (x1[q][0] * x1[q][0] + x1[q][1] * x1[q][1]) + (x1[q][2] * x1[q][2] + x1[q][3] * x1[q][3]); }
#pragma unroll
        for (int o = 1; o < 64; o <<= 1)
#pragma unroll
            for (int q = 0; q < 4; ++q) sq[q] += __shfl_xor(sq[q], o);
#pragma unroll
        for (int q = 0; q < 4; ++q) { const int t = 4 * wid + q;
            const float rstd = 1.0f / sqrtf(sq[q] * (1.0f / 512.0f) + EPS);
            const f32x4 y0 = x0[q] * rstd * g0 + b0, y1 = x1[q] * rstd * g1 + b1;
            u32x4 o; o.x = cvt_pk_bf16(silu_f(y0[0]), silu_f(y0[1])); o.y = cvt_pk_bf16(silu_f(y0[2]), silu_f(y0[3])); o.z = cvt_pk_bf16(silu_f(y1[0]), silu_f(y1[1])); o.w = cvt_pk_bf16(silu_f(y1[2]), silu_f(y1[3]));
            *(LAS u32x4*)(lds + t * CV_A_ROWB + lane * 16) = o; }
    }
    __syncthreads();
    {
        f32x4 acc[4][2];
#pragma unroll
        for (int nt = 0; nt < 4; ++nt) { acc[nt][0] = (f32x4){0.f, 0.f, 0.f, 0.f}; acc[nt][1] = (f32x4){0.f, 0.f, 0.f, 0.f}; }
#pragma unroll
        for (int ks = 0; ks < 16; ++ks) {
            if (ks < 13) {
#pragma unroll
                for (int nt = 0; nt < 4; ++nt) pfb[(ks + 3) & 3][nt] = *(const bf16x8*)(pw + (size_t)(16 * nt) * 512 + 32 * (ks + 3));
            }
            SCHED_BAR();
            bf16x8 af[2];
#pragma unroll
            for (int tt = 0; tt < 2; ++tt) af[tt] = *(const LAS bf16x8*)(lds + (16 * tt + fr) * CV_A_ROWB + (32 * ks + 8 * fq) * 2);
#pragma unroll
            for (int nt = 0; nt < 4; ++nt) {
                acc[nt][0] = __builtin_amdgcn_mfma_f32_16x16x32_bf16(pfb[ks & 3][nt], af[0], acc[nt][0], 0, 0, 0);
                acc[nt][1] = __builtin_amdgcn_mfma_f32_16x16x32_bf16(pfb[ks & 3][nt], af[1], acc[nt][1], 0, 0, 0); }
            SCHED_BAR();
        }
        REOPAQUE();
        u32x2 gwv[2][4]; f32x4 pbv[4];
#pragma unroll
        for (int nt = 0; nt < 4; ++nt) { const int n4 = 64 * wid + 16 * nt + 4 * fq; pbv[nt] = *(const f32x4*)(pwb + n4);
#pragma unroll
            for (int tt = 0; tt < 2; ++tt) gwv[tt][nt] = *(const u32x2*)(Z + (size_t)(b * SEQ + t0 + 16 * tt + fr) * DIN + OFF_GC + n4); }
        SCHED_BAR();
#pragma unroll
        for (int tt = 0; tt < 2; ++tt) {
            const int tok = b * SEQ + t0 + 16 * tt + fr;
#pragma unroll
            for (int nt = 0; nt < 4; ++nt) {
                const int n4 = 64 * wid + 16 * nt + 4 * fq;
                const f32x4 pb = pbv[nt]; const u32x2 gw = gwv[tt][nt];
                const float g0 = silu_f(bf_lo(gw.x)), g1 = silu_f(bf_hi(gw.x)), g2 = silu_f(bf_lo(gw.y)), g3 = silu_f(bf_hi(gw.y));
                u32x2 o; o.x = cvt_pk_bf16((acc[nt][tt][0] + pb[0]) * g0, (acc[nt][tt][1] + pb[1]) * g1); o.y = cvt_pk_bf16((acc[nt][tt][2] + pb[2]) * g2, (acc[nt][tt][3] + pb[3]) * g3);
                *(u32x2*)(YC + (size_t)tok * DMIX + 1536 + n4) = o;
            }
        }
    }
    __syncthreads();
#undef REOPAQUE
}

#define XB_TMO      128
#define XB_XCNT(j)  (256  + 64 * (j))
#define XB_XSUB(j)  (1280 + 64 * (j))
#define XB_XGEN(j)  (2304 + 64 * (j))
#define XB_TOP      3328
#define XB_TOPGEN   3392
#define XCD_BAR_WORDS 3456
#define XB_SPIN_CAP (1u << 18)

__device__ __forceinline__ unsigned xb_ld(unsigned* p)              { return __hip_atomic_load(p, __ATOMIC_RELAXED, __HIP_MEMORY_SCOPE_AGENT); }
__device__ __forceinline__ unsigned xb_add(unsigned* p, unsigned v) { return __hip_atomic_fetch_add(p, v, __ATOMIC_RELAXED, __HIP_MEMORY_SCOPE_AGENT); }
__device__ __forceinline__ unsigned xb_xcc_id() { return (unsigned)__builtin_amdgcn_s_getreg((3 << 11) | 20) & 0xFu; }
#define XB_SPIN(cond, bar) do { unsigned _sp = 0; while (cond) { __builtin_amdgcn_s_sleep(1); \
    if ((++_sp & 255u) == 0u) { if (xb_ld(&(bar)[XB_TMO])) break; if (_sp > XB_SPIN_CAP) { atomicAdd(&(bar)[XB_TMO], 1u); break; } } } } while (0)

struct XcdBarrier {
    unsigned* bar; unsigned x;
    volatile LAS unsigned* st;
};

__device__ __forceinline__ XcdBarrier xcd_barrier_post(unsigned* bar, volatile LAS unsigned* st) {
    XcdBarrier b; b.bar = bar; b.x = xb_xcc_id(); b.st = st;
    if (threadIdx.x == 0) (void)xb_add(&bar[XB_XCNT(b.x)], 1u);
    return b;
}
__device__ __forceinline__ void xcd_barrier_complete(unsigned* bar, unsigned x, unsigned& nloc, unsigned& nx) {
    const unsigned G = gridDim.x * gridDim.y * gridDim.z;
    unsigned sum, cnt, mine, sp = 0u;
    for (;;) {
        sum = 0u; cnt = 0u; mine = 0u;
#pragma unroll
        for (unsigned j = 0; j < 16; ++j) { const unsigned c = xb_ld(&bar[XB_XCNT(j)]); sum += c; cnt += (c > 0u) ? 1u : 0u; mine = (j == x) ? c : mine; }
        if (sum == G) break;
        __builtin_amdgcn_s_sleep(1);
        if ((++sp & 255u) == 0u) { if (xb_ld(&bar[XB_TMO])) break; if (sp > XB_SPIN_CAP) { atomicAdd(&bar[XB_TMO], 1u); break; } }
    }
    nloc = mine > 0u ? mine : 1u; nx = cnt > 0u ? cnt : 1u;
}

__device__ __forceinline__ void xcd_barrier(const XcdBarrier& b) {
    asm volatile("s_waitcnt vmcnt(0)" ::: "memory");
    __syncthreads();
    if (threadIdx.x == 0) {
        unsigned* bar = b.bar;
        __builtin_amdgcn_s_waitcnt(0);
        unsigned nloc = b.st[0], nx = b.st[1];
        if (nloc == 0u) { xcd_barrier_complete(bar, b.x, nloc, nx); b.st[0] = nloc; b.st[1] = nx; }
        const unsigned old = xb_add(&bar[XB_XSUB(b.x)], 1u);
        const unsigned gen = old / nloc;
        if (old + 1u == (gen + 1u) * nloc) {
            __builtin_amdgcn_fence(__ATOMIC_RELEASE, "agent");
            asm volatile("s_waitcnt vmcnt(0)" ::: "memory");
            const unsigned og = xb_add(&bar[XB_TOP], 1u);
            const unsigned tg = og / nx;
            if (og + 1u == (tg + 1u) * nx) xb_add(&bar[XB_TOPGEN], 1u);
            else XB_SPIN(xb_ld(&bar[XB_TOPGEN]) == tg, bar);
            __builtin_amdgcn_fence(__ATOMIC_ACQUIRE, "agent");
            xb_add(&bar[XB_XGEN(b.x)], 1u);
            asm volatile("s_waitcnt vmcnt(0)" ::: "memory");
        } else {
            XB_SPIN(xb_ld(&bar[XB_XGEN(b.x)]) == gen, bar);
            __builtin_amdgcn_fence(__ATOMIC_ACQUIRE, "agent");
            asm volatile("s_waitcnt vmcnt(0)" ::: "memory");
        }
    }
    __syncthreads();
}

struct Params { const float* in[16]; float* out; unsigned char* ws; unsigned long long use_cg; };

__global__ void __launch_bounds__(512, 2) fwd_megakernel(Params p) {
    extern __shared__ __attribute__((aligned(16))) unsigned char lds_raw[];
    cg::grid_group grid = cg::this_grid();
    LAS unsigned char* lds = (LAS unsigned char*)lds_raw;
    const int G = gridDim.x, bx = blockIdx.x, NGW = G * 8;
    { volatile LAS unsigned* misc = (volatile LAS unsigned*)(lds + 131072); if (threadIdx.x < 64) misc[threadIdx.x] = 0u; }
    __syncthreads();
    XcdBarrier bar = xcd_barrier_post((unsigned*)(p.ws + WS_CTL), (volatile LAS unsigned*)(lds + 131072));
#define GRID_BAR() do { if (p.use_cg) grid.sync(); else xcd_barrier(bar); } while (0)
#define FRESH_IDS() int tid = threadIdx.x; asm volatile("" : "+v"(tid)); const int lane = tid & 63, wid = __builtin_amdgcn_readfirstlane(tid >> 6); const int gw = bx * 8 + wid; (void)gw; (void)lane
    unsigned char* ws = p.ws;
    const float* x = p.in[0]; const float* pre_g = p.in[1]; const float* w_in = p.in[2]; const float* rpb = p.in[3];
    const float* sgu_ln_g = p.in[4]; const float* sgu_ln_b = p.in[5]; const float* sgu_w = p.in[6]; const float* sgu_b = p.in[7];
    const float* conv_w = p.in[8]; const float* conv_b = p.in[9]; const float* conv_ln_g = p.in[10]; const float* conv_ln_b = p.in[11];
    const float* conv_pw_w = p.in[12]; const float* conv_pw_b = p.in[13]; const float* w_out = p.in[14]; const float* post_g = p.in[15];
    bf16_t* WinT = (bf16_t*)(ws + WS_WIN); bf16_t* WoutT = (bf16_t*)(ws + WS_WOUT); bf16_t* PwT = (bf16_t*)(ws + WS_PW); bf16_t* SgW = (bf16_t*)(ws + WS_SGW);
    float* SSQ = (float*)(ws + WS_SSQ); bf16_t* H = (bf16_t*)(ws + WS_H); bf16_t* Z = (bf16_t*)(ws + WS_Z); bf16_t* VT = (bf16_t*)(ws + WS_VT);
    bf16_t* YC = (bf16_t*)(ws + WS_YC); float* Y = (float*)(ws + WS_Y); float* X1 = (float*)(ws + WS_X1);

    {
        FRESH_IDS();
        LAS float* scr = (LAS float*)(lds + wid * 16384);
        constexpr int I_IN = (DM / 64) * (DIN / 32), I_PW = (512 / 64) * (512 / 32);
        constexpr int NITEMS = I_IN + 2 * I_PW;
        for (int it = gw; it < NITEMS; it += NGW) {
            int r = it;
            if (r < I_IN) { p0_transpose_item(w_in, DM, DIN, WinT, scr, r, lane); continue; } r -= I_IN;
            { const int l = r / I_PW; p0_transpose_item(conv_pw_w + (size_t)l * 512 * 512, 512, 512, PwT + (size_t)l * 512 * 512, scr, r % I_PW, lane); }
        }
        for (int i = gw * 64 + lane; i < 2 * 4 * 128 * 128 / 2; i += NGW * 64) { const f32x2 v = *(const f32x2*)(sgu_w + 2 * (size_t)i); ((unsigned*)SgW)[i] = cvt_pk_bf16(v[0], v[1]); }
        for (int m = gw; m < MTOK; m += NGW) row_update<false, false, true>(x + (size_t)m * DM, nullptr, nullptr, nullptr, pre_g, nullptr, H + (size_t)m * DM, lane);
    }
    GRID_BAR();

#pragma unroll 1
    for (int l = 0; l < DEPTH; ++l) {
        const float* xin = (l == 0) ? x : X1;
        float* xout = (l == DEPTH - 1) ? p.out : X1;
        {
            const bf16_t* W = WinT + (size_t)l * DIN * DM;
            { pg8::Gemm g{H, W, MTOK, DIN - 1024, DM}; pg8::StaticOrder S; S.init(MTOK, DIN - 1024, G, bx, 8, 4); pg8::EpiBf16 E{Z, DIN};
              pg8::gemm_phase<pg8::EpiBf16, pg8::StaticOrder>(lds, g, S, E); }
            const int cvt_first = (G > 128) ? 128 : 0;
            if (l == 0 && bx >= cvt_first) {
                FRESH_IDS();
                LAS float* scr = (LAS float*)(lds + wid * 16384);
                constexpr int I_IN = (DM / 64) * (DIN / 32), I_OUT = (DMIX / 64) * (DM / 32);
                const int gw2 = (bx - cvt_first) * 8 + wid, NGW2 = (G - cvt_first) * 8;
                for (int it = gw2; it < I_IN + 2 * I_OUT; it += NGW2) {
                    int r = it;
                    if (r < I_OUT) { p0_transpose_item(w_out, DMIX, DM, WoutT, scr, r, lane); continue; } r -= I_OUT;
                    if (r < I_IN) { p0_transpose_item(w_in + (size_t)DM * DIN, DM, DIN, WinT + (size_t)DIN * DM, scr, r, lane); continue; } r -= I_IN;
                    p0_transpose_item(w_out + (size_t)DMIX * DM, DMIX, DM, WoutT + (size_t)DM * DMIX, scr, r, lane);
                }
            }
            { pg8::Gemm g{W + (size_t)OFF_V * DM, H, 1024, MTOK, DM}; pg8::StaticOrder S; S.init(1024, MTOK, G, bx, 1 << 30, 0); pg8::EpiBf16 E{VT, MTOK};
              pg8::gemm_phase<pg8::EpiBf16, pg8::StaticOrder>(lds, g, S, E); }
        }
        GRID_BAR();
        {
            { FRESH_IDS();
            for (int it = bx; it < 256; it += G)
                conv_item(lds, Z, PwT + (size_t)l * 512 * 512, conv_w + (size_t)l * 31 * 512, conv_b + l * 512, conv_ln_g + l * 512, conv_ln_b + l * 512, conv_pw_b + l * 512, YC, it, tid, wid, lane); }
            { FRESH_IDS();
            for (int it = bx; it < 256; it += G)
                sgu_item(lds, Z, SgW + (size_t)l * 4 * 128 * 128, sgu_ln_g + l * 512, sgu_ln_b + l * 512, sgu_b + l * 512, YC, it, wid, lane); }
            { FRESH_IDS();
            LAS float* rpbl = (LAS float*)(lds + 132096);
            { float rv[8];
#pragma unroll
              for (int k = 0; k < 8; ++k) { const int i = tid + 512 * k; rv[k] = (i < 8 * 15 * 31) ? rpb[(size_t)l * 8 * 15 * 31 + i] : 0.f; }
#pragma unroll
              for (int k = 0; k < 8; ++k) { const int i = tid + 512 * k; if (i < 8 * 15 * 31) rpbl[i] = rv[k]; } }
            __syncthreads();
            const int vb0 = (G == 256) ? ((bx & 7) * 32 + (bx >> 3)) : bx;
            for (int vb = vb0; vb < 256; vb += G)
#pragma unroll 1
                for (int k = 0; k < 2; ++k) { const int id = 2 * vb + k, pair = id >> 4;
                    attn_block_item(lds, rpbl, Z, VT, YC, pair >> 3, pair & 7, (id >> 2) & 3, id & 3, tid, wid, lane); }
            }
        }
        GRID_BAR();
        {
            pg8::Gemm g{YC, WoutT + (size_t)l * DM * DMIX, MTOK, DM, DMIX}; pg8::StaticOrder S; S.init(MTOK, DM, G, bx, 1 << 30, 0); pg8::EpiF32Ssq E{Y, DM, SSQ};
            pg8::gemm_phase<pg8::EpiF32Ssq, pg8::StaticOrder>(lds, g, S, E);
        }
        GRID_BAR();
        if (l == 0) {
            FRESH_IDS();
            for (int m = gw; m < MTOK; m += NGW)
                row_update<true, true, true>(xin + (size_t)m * DM, Y + (size_t)m * DM, SSQ + (size_t)m * 32, post_g + l * DM, pre_g + (l + 1) * DM, xout + (size_t)m * DM, H + (size_t)m * DM, lane);
            GRID_BAR();
        } else {
            FRESH_IDS();
            for (int m = gw; m < MTOK; m += NGW)
                row_update<true, true, false>(xin + (size_t)m * DM, Y + (size_t)m * DM, SSQ + (size_t)m * 32, post_g + l * DM, nullptr, xout + (size_t)m * DM, nullptr, lane);
        }
    }
}

extern "C" void kernel_launch(void* const* d_in, const int* in_sizes, int n_in, void* d_out, int out_size, void* d_ws, size_t ws_size, hipStream_t stream) {
    static int grid_blocks = 0;
    if (grid_blocks == 0) {
        if (n_in != 16 || ws_size < WS_END) { fprintf(stderr, "kernel_launch: unexpected n_in %d / ws_size %zu\n", n_in, ws_size); grid_blocks = -1; return; }
        int dev = 0, cus = 0, per_cu = 0;
        hipGetDevice(&dev);
        hipDeviceGetAttribute(&cus, hipDeviceAttributeMultiprocessorCount, dev);
        if (hipFuncSetAttribute((const void*)fwd_megakernel, hipFuncAttributeMaxDynamicSharedMemorySize, LDS_BYTES) != hipSuccess) fprintf(stderr, "kernel_launch: hipFuncSetAttribute failed\n");
        if (hipOccupancyMaxActiveBlocksPerMultiprocessor(&per_cu, (const void*)fwd_megakernel, 512, LDS_BYTES) != hipSuccess || per_cu < 1) { fprintf(stderr, "kernel_launch: occupancy query says %d\n", per_cu); per_cu = 1; }
        (void)hipGetLastError();
        grid_blocks = cus * 1;
    }
    if (grid_blocks < 0) return;
    if (hipMemsetAsync((char*)d_ws + WS_CTL, 0, CTL_BYTES, stream) != hipSuccess) { fprintf(stderr, "kernel_launch: memset failed\n"); return; }
    Params p{};
    for (int i = 0; i < 16; ++i) p.in[i] = (const float*)d_in[i];
    p.out = (float*)d_out; p.ws = (unsigned char*)d_ws;
    void* args[] = {&p};
    hipError_t e = hipLaunchCooperativeKernel((const void*)fwd_megakernel, dim3(grid_blocks), dim3(512), args, LDS_BYTES, stream);
    if (e != hipSuccess) fprintf(stderr, "cooperative launch failed: %s (grid %d)\n", hipGetErrorString(e), grid_blocks);
}
```
